# Optimizing an MI355X kernel written in HIP

```python
import math
import jax, jax.numpy as jnp
from jax import lax
import numpy as np

D_MODEL = 1024
BATCH = 16
SEQ = 2048
DEPTH = 2
DEC_BATCH = 4
DEC_SEQ = 8192
PAST_LEN = 128

N_META = 16
N_EVEN = (DEPTH + 1) // 2
N_ODD = DEPTH // 2
D_A = D_MODEL // 2
S5_GROUP = 16
G_A = D_A // S5_GROUP
S5_STATE = 64
D_B = D_MODEL // 2
H_B = 8
BW_B = D_B // H_B
LRU_C = 8.0
CONV_B = 4
CONV_B_LEFT = 2
D_IN_AB = D_A + 2 * D_B
D_MIX_AB = D_A + D_B
HEAD_DIM = 64
N_Q_HEADS = D_MODEL // HEAD_DIM
N_KV_HEADS = 4
GQ = N_Q_HEADS // N_KV_HEADS
D_QKV = (N_Q_HEADS + 2 * N_KV_HEADS) * HEAD_DIM
WINDOW = 128
BLOCK = 128
D_FF = 2816
CONV_F = 3
EPS = 1e-6
NEG = -1e30

kernel_name = 'hybrid_s5_rglru_swa_encoder'


def rmsnorm(x, g):
    xf = x.astype(jnp.float32)
    y = xf * lax.rsqrt(jnp.mean(xf * xf, axis=-1, keepdims=True) + EPS) * g.astype(jnp.float32)
    return y.astype(x.dtype)


def dwconv(x, w, b, left):
    k_width = w.shape[0]
    length = x.shape[1]
    xp = jnp.pad(x, ((0, 0), (left, k_width - 1 - left), (0, 0)))
    out = xp[:, 0:length] * w[0]
    for k in range(1, k_width):
        out = out + xp[:, k:k + length] * w[k]
    return out + b


def _linear_combine(e1, e2):
    a1, b1 = e1
    a2, b2 = e2
    return (a1 * a2, a2 * b1 + b2)


def s5_mixer(u, lam_re, lam_im, log_dt, b_re, b_im, c_re, c_im, d_skip, w_glu, b_glu):
    bsz, length, _ = u.shape
    uf = u.astype(jnp.float32).reshape(bsz, length, G_A, S5_GROUP)
    uc = uf.astype(jnp.complex64)
    y = uf * d_skip.astype(jnp.float32).reshape(G_A, S5_GROUP)
    for direction in range(2):
        lam = lax.complex(jnp.minimum(lam_re[direction].astype(jnp.float32), -1e-4),
                          lam_im[direction].astype(jnp.float32))
        dt = jnp.exp(log_dt[direction].astype(jnp.float32))[:, None]
        lam_bar = jnp.exp(lam * dt)
        b_mat = lax.complex(b_re[direction].astype(jnp.float32), b_im[direction].astype(jnp.float32))
        b_bar = ((lam_bar - 1.0) / lam)[:, :, None] * b_mat
        bu = jnp.einsum('blgc,gnc->blgn', uc, b_bar)
        a = jnp.broadcast_to(lam_bar, bu.shape)
        _, states = lax.associative_scan(_linear_combine, (a, bu), axis=1, reverse=(direction == 1))
        c_mat = lax.complex(c_re[direction].astype(jnp.float32), c_im[direction].astype(jnp.float32))
        y = y + jnp.real(jnp.einsum('blgn,gcn->blgc', states, c_mat))
    y = jax.nn.gelu(y.reshape(bsz, length, D_A))
    y = y * jax.nn.sigmoid(y @ w_glu.astype(jnp.float32) + b_glu.astype(jnp.float32))
    return y.astype(u.dtype)


def rglru_direction(x, w_r, b_r, w_i, b_i, lam, reverse):
    bsz, length, _ = x.shape
    xh = x.reshape(bsz, length, H_B, BW_B)
    r = jax.nn.sigmoid(jnp.einsum('blhi,hij->blhj', xh, w_r.astype(jnp.float32)).reshape(bsz, length, D_B) + b_r.astype(jnp.float32))
    i = jax.nn.sigmoid(jnp.einsum('blhi,hij->blhj', xh, w_i.astype(jnp.float32)).reshape(bsz, length, D_B) + b_i.astype(jnp.float32))
    log_a = -LRU_C * r * jax.nn.softplus(-lam.astype(jnp.float32))
    a = jnp.exp(log_a)
    inp = jnp.sqrt(-jnp.expm1(2.0 * log_a)) * (i * x)
    _, h = lax.associative_scan(_linear_combine, (a, inp), axis=1, reverse=reverse)
    return h


def rglru_mixer(xb, gate, conv_w, conv_b, w_r, b_r, w_i, b_i, lam):
    xc = dwconv(xb, conv_w, conv_b, CONV_B_LEFT).astype(jnp.float32)
    h = (rglru_direction(xc, w_r[0], b_r[0], w_i[0], b_i[0], lam[0], False)
         + rglru_direction(xc, w_r[1], b_r[1], w_i[1], b_i[1], lam[1], True))
    return (h * jax.nn.gelu(gate.astype(jnp.float32))).astype(xb.dtype)


def ab_layer(h, w_in, lam_re, lam_im, log_dt, b_re, b_im, c_re, c_im, d_skip, w_glu, b_glu,
             conv_w, conv_b, w_r, b_r, w_i, b_i, lam, w_out):
    z = h @ w_in
    u_a = z[..., :D_A]
    x_b = z[..., D_A:D_A + D_B]
    g_b = z[..., D_A + D_B:]
    y_a = s5_mixer(u_a, lam_re, lam_im, log_dt, b_re, b_im, c_re, c_im, d_skip, w_glu, b_glu)
    y_b = rglru_mixer(x_b, g_b, conv_w, conv_b, w_r, b_r, w_i, b_i, lam)
    return jnp.concatenate([y_a, y_b], axis=-1) @ w_out


def alibi_slopes():
    return 2.0 ** (-8.0 * jnp.arange(1, N_Q_HEADS + 1, dtype=jnp.float32) / N_Q_HEADS)


def windowed_gqa(h, w_qkv, w_o, sink):
    bsz, length, _ = h.shape
    qkv = h @ w_qkv
    q = qkv[..., :N_Q_HEADS * HEAD_DIM].reshape(bsz, length, N_KV_HEADS, GQ, HEAD_DIM)
    k = qkv[..., N_Q_HEADS * HEAD_DIM:(N_Q_HEADS + N_KV_HEADS) * HEAD_DIM].reshape(bsz, length, N_KV_HEADS, HEAD_DIM)
    v = qkv[..., (N_Q_HEADS + N_KV_HEADS) * HEAD_DIM:].reshape(bsz, length, N_KV_HEADS, HEAD_DIM)
    front = BLOCK - N_META
    lp = length + front
    nb = lp // BLOCK
    qp = jnp.pad(q, ((0, 0), (front, 0), (0, 0), (0, 0), (0, 0))).reshape(bsz, nb, BLOCK, N_KV_HEADS, GQ, HEAD_DIM)
    kp = jnp.pad(k, ((0, 0), (front + BLOCK, BLOCK), (0, 0), (0, 0))).reshape(bsz, nb + 2, BLOCK, N_KV_HEADS, HEAD_DIM)
    vp = jnp.pad(v, ((0, 0), (front + BLOCK, BLOCK), (0, 0), (0, 0))).reshape(bsz, nb + 2, BLOCK, N_KV_HEADS, HEAD_DIM)
    kb = jnp.concatenate([kp[:, :-2], kp[:, 1:-1], kp[:, 2:]], axis=2)
    vb = jnp.concatenate([vp[:, :-2], vp[:, 1:-1], vp[:, 2:]], axis=2)
    s = jnp.einsum('bnqhgd,bnkhd->bnhgqk', qp, kb).astype(jnp.float32) * (1.0 / math.sqrt(HEAD_DIM))
    qi = jnp.arange(BLOCK)
    ki = jnp.arange(3 * BLOCK)
    dist = jnp.abs(qi[:, None] + BLOCK - ki[None, :])
    key_pos = (jnp.arange(nb)[:, None] - 1) * BLOCK + ki[None, :]
    key_ok = (key_pos >= front) & (key_pos < lp)
    mask = (dist <= WINDOW)[None] & key_ok[:, None, :]
    slopes = alibi_slopes().reshape(N_KV_HEADS, GQ)
    s = s - slopes[:, :, None, None] * dist.astype(jnp.float32)
    s = jnp.where(mask[None, :, None, None], s, NEG)
    sink_l = sink.astype(jnp.float32).reshape(N_KV_HEADS, GQ)[None, None, :, :, None]
    m = jnp.maximum(jnp.max(s, axis=-1), sink_l)
    p = jnp.exp(s - m[..., None])
    denom = jnp.sum(p, axis=-1) + jnp.exp(sink_l - m)
    o = jnp.einsum('bnhgqk,bnkhd->bnqhgd', p.astype(vb.dtype), vb)
    o = o / jnp.moveaxis(denom, -1, 2)[..., None].astype(o.dtype)
    o = o.reshape(bsz, lp, N_Q_HEADS * HEAD_DIM)[:, front:]
    return o @ w_o


def conv_ffn(h, w_up, conv_w, conv_b, w_down):
    u = dwconv(h @ w_up, conv_w, conv_b, CONV_F // 2)
    a = u[..., :D_FF]
    g = u[..., D_FF:]
    return (jax.nn.gelu(g) * a) @ w_down


def trunk(x, meta_tokens, norm_mix_g, norm_ffn_g, final_norm_g, w_in_ab, s5_lambda_re, s5_lambda_im,
          s5_log_dt, s5_b_re, s5_b_im, s5_c_re, s5_c_im, s5_d, w_glu, b_glu, lru_conv_w, lru_conv_b,
          lru_w_r, lru_b_r, lru_w_i, lru_b_i, lru_lambda, w_out_ab, w_qkv, w_o, attn_sink,
          w_up, ffn_conv_w, ffn_conv_b, w_down):
    bsz = x.shape[0]
    meta = jnp.broadcast_to(meta_tokens[None].astype(x.dtype), (bsz, N_META, D_MODEL))
    h = jnp.concatenate([meta, x], axis=1)
    for layer in range(DEPTH):
        j = layer // 2
        hn = rmsnorm(h, norm_mix_g[layer])
        if layer % 2 == 0:
            h = h + ab_layer(hn, w_in_ab[j], s5_lambda_re[j], s5_lambda_im[j], s5_log_dt[j], s5_b_re[j],
                             s5_b_im[j], s5_c_re[j], s5_c_im[j], s5_d[j], w_glu[j], b_glu[j],
                             lru_conv_w[j], lru_conv_b[j], lru_w_r[j], lru_b_r[j], lru_w_i[j], lru_b_i[j],
                             lru_lambda[j], w_out_ab[j])
        else:
            h = h + windowed_gqa(hn, w_qkv[j], w_o[j], attn_sink[j])
        h = h + conv_ffn(rmsnorm(h, norm_ffn_g[layer]), w_up[layer], ffn_conv_w[layer], ffn_conv_b[layer], w_down[layer])
    h = rmsnorm(h, final_norm_g)
    return h[:, N_META:]


def setup_inputs(seed: int = 0) -> dict:
    key = jax.random.key(seed)
    ks = iter(jax.random.split(key, 40))
    f32 = jnp.float32

    def nrm(shape, scale):
        return jax.random.normal(next(ks), shape, f32) * scale

    x_prompt = nrm((BATCH, SEQ, D_MODEL), 1.0)
    x_sample = nrm((DEC_BATCH, DEC_SEQ, D_MODEL), 1.0)
    meta_tokens = nrm((N_META, D_MODEL), 1.0)
    norm_mix_g = 1.0 + nrm((DEPTH, D_MODEL), 0.02)
    norm_ffn_g = 1.0 + nrm((DEPTH, D_MODEL), 0.02)
    final_norm_g = 1.0 + nrm((D_MODEL,), 0.02)
    w_in_ab = nrm((N_EVEN, D_MODEL, D_IN_AB), D_MODEL ** -0.5)
    s5_lambda_re = -0.5 + nrm((N_EVEN, 2, G_A, S5_STATE), 0.01)
    s5_lambda_im = math.pi * jnp.arange(S5_STATE, dtype=f32) + nrm((N_EVEN, 2, G_A, S5_STATE), 0.01)
    s5_log_dt = jax.random.uniform(next(ks), (N_EVEN, 2, G_A), f32, math.log(1e-3), math.log(1e-1))
    s5_b_re = nrm((N_EVEN, 2, G_A, S5_STATE, S5_GROUP), (2 * S5_GROUP) ** -0.5)
    s5_b_im = nrm((N_EVEN, 2, G_A, S5_STATE, S5_GROUP), (2 * S5_GROUP) ** -0.5)
    s5_c_re = nrm((N_EVEN, 2, G_A, S5_GROUP, S5_STATE), S5_STATE ** -0.5)
    s5_c_im = nrm((N_EVEN, 2, G_A, S5_GROUP, S5_STATE), S5_STATE ** -0.5)
    s5_d = nrm((N_EVEN, D_A), 1.0)
    w_glu = nrm((N_EVEN, D_A, D_A), D_A ** -0.5)
    b_glu = nrm((N_EVEN, D_A), 0.01)
    lru_conv_w = nrm((N_EVEN, CONV_B, D_B), CONV_B ** -0.5)
    lru_conv_b = nrm((N_EVEN, D_B), 0.01)
    lru_w_r = nrm((N_EVEN, 2, H_B, BW_B, BW_B), BW_B ** -0.5)
    lru_b_r = nrm((N_EVEN, 2, D_B), 0.01)
    lru_w_i = nrm((N_EVEN, 2, H_B, BW_B, BW_B), BW_B ** -0.5)
    lru_b_i = nrm((N_EVEN, 2, D_B), 0.01)
    a_c = jax.random.uniform(next(ks), (N_EVEN, 2, D_B), f32, 0.9, 0.999)
    sig = a_c ** (1.0 / LRU_C)
    lru_lambda = jnp.log(sig) - jnp.log1p(-sig)
    w_out_ab = nrm((N_EVEN, D_MIX_AB, D_MODEL), D_MIX_AB ** -0.5)
    w_qkv = nrm((N_ODD, D_MODEL, D_QKV), D_MODEL ** -0.5)
    w_o = nrm((N_ODD, N_Q_HEADS * HEAD_DIM, D_MODEL), (N_Q_HEADS * HEAD_DIM) ** -0.5)
    attn_sink = nrm((N_ODD, N_Q_HEADS), 0.5)
    w_up = nrm((DEPTH, D_MODEL, 2 * D_FF), D_MODEL ** -0.5)
    ffn_conv_w = nrm((DEPTH, CONV_F, 2 * D_FF), CONV_F ** -0.5)
    ffn_conv_b = nrm((DEPTH, 2 * D_FF), 0.01)
    w_down = nrm((DEPTH, D_FF, D_MODEL), D_FF ** -0.5)
    return {'x_prompt': x_prompt, 'x_sample': x_sample, 'meta_tokens': meta_tokens,
            'norm_mix_g': norm_mix_g, 'norm_ffn_g': norm_ffn_g, 'final_norm_g': final_norm_g,
            'w_in_ab': w_in_ab, 's5_lambda_re': s5_lambda_re, 's5_lambda_im': s5_lambda_im,
            's5_log_dt': s5_log_dt, 's5_b_re': s5_b_re, 's5_b_im': s5_b_im, 's5_c_re': s5_c_re,
            's5_c_im': s5_c_im, 's5_d': s5_d, 'w_glu': w_glu, 'b_glu': b_glu,
            'lru_conv_w': lru_conv_w, 'lru_conv_b': lru_conv_b, 'lru_w_r': lru_w_r, 'lru_b_r': lru_b_r,
            'lru_w_i': lru_w_i, 'lru_b_i': lru_b_i, 'lru_lambda': lru_lambda, 'w_out_ab': w_out_ab,
            'w_qkv': w_qkv, 'w_o': w_o, 'attn_sink': attn_sink, 'w_up': w_up,
            'ffn_conv_w': ffn_conv_w, 'ffn_conv_b': ffn_conv_b, 'w_down': w_down}


def reference(x_prompt, x_sample, meta_tokens, norm_mix_g, norm_ffn_g, final_norm_g, w_in_ab,
              s5_lambda_re, s5_lambda_im, s5_log_dt, s5_b_re, s5_b_im, s5_c_re, s5_c_im, s5_d,
              w_glu, b_glu, lru_conv_w, lru_conv_b, lru_w_r, lru_b_r, lru_w_i, lru_b_i, lru_lambda,
              w_out_ab, w_qkv, w_o, attn_sink, w_up, ffn_conv_w, ffn_conv_b, w_down):
    params = (meta_tokens, norm_mix_g, norm_ffn_g, final_norm_g, w_in_ab, s5_lambda_re, s5_lambda_im,
              s5_log_dt, s5_b_re, s5_b_im, s5_c_re, s5_c_im, s5_d, w_glu, b_glu, lru_conv_w, lru_conv_b,
              lru_w_r, lru_b_r, lru_w_i, lru_b_i, lru_lambda, w_out_ab, w_qkv, w_o, attn_sink,
              w_up, ffn_conv_w, ffn_conv_b, w_down)
    y_prompt = trunk(x_prompt, *params)
    y_sample = trunk(x_sample, *params)
    return (y_prompt, y_sample)
```

```cpp
#include <hip/hip_runtime.h>
#include <hip/hip_cooperative_groups.h>
#include <cstdio>
namespace cg = cooperative_groups;

#define LAS __attribute__((address_space(3)))
typedef unsigned short bf16_t;
typedef short bf16x8 __attribute__((ext_vector_type(8)));
typedef short bf16x4 __attribute__((ext_vector_type(4)));
typedef float f32x4 __attribute__((ext_vector_type(4)));
typedef float f32x16 __attribute__((ext_vector_type(16)));
typedef unsigned u32x2 __attribute__((ext_vector_type(2)));
typedef unsigned u32x4 __attribute__((ext_vector_type(4)));

constexpr int DM = 1024;
constexpr int LP = 2064, LS = 8208;
constexpr int RP = 16 * LP;
constexpr int R = RP + 4 * LS;
constexpr int MP = 66048;
constexpr int NT256 = 258;
constexpr int NTUP = 266;
constexpr int DFF = 2816;
constexpr int RSPLIT = 59392;
constexpr float EPS = 1e-6f;

constexpr size_t SZ_WIN = 1536ull * 1024 * 2, SZ_WGLU = 512ull * 512 * 2, SZ_WSQ = 1024ull * 1024 * 2, SZ_WUP = 5632ull * 1024 * 2, SZ_WDN = 1024ull * 2816 * 2;
constexpr size_t OFF_BAR = 0, SZ_BAR = 16384;
constexpr size_t OFF_WIN = OFF_BAR + SZ_BAR;
constexpr size_t OFF_WGLU = OFF_WIN + SZ_WIN;
constexpr size_t OFF_WOUT = OFF_WGLU + SZ_WGLU;
constexpr size_t OFF_WQKV = OFF_WOUT + SZ_WSQ;
constexpr size_t OFF_WO = OFF_WQKV + SZ_WIN;
constexpr size_t OFF_WUP0 = OFF_WO + SZ_WSQ;
constexpr size_t OFF_WUP1 = OFF_WUP0 + SZ_WUP;
constexpr size_t OFF_WDN0 = OFF_WUP1 + SZ_WUP;
constexpr size_t OFF_WDN1 = OFF_WDN0 + SZ_WDN;
constexpr size_t OFF_RSS = OFF_WDN1 + SZ_WDN;
constexpr size_t SZ_RSS = (size_t)MP * 16 * 4;
constexpr size_t OFF_HPAD = OFF_RSS + SZ_RSS;
constexpr size_t SZ_H = (size_t)(MP + 8) * 1024 * 2;
constexpr size_t OFF_DYN = OFF_HPAD + SZ_H;
constexpr size_t SZ_Z = (size_t)MP * 1536 * 2;
constexpr size_t SZ_ROWS = (size_t)MP * 1024 * 2;
constexpr size_t SZ_QK = (size_t)MP * 1280 * 2;
constexpr size_t SZ_VT = 256ull * MP * 2;
constexpr size_t DYN_SIZE = 2 * SZ_ROWS + 2 * SZ_VT;
constexpr size_t WS_NEED = OFF_DYN + DYN_SIZE;
constexpr int LDS_STAGE = 131072, AUX_OFF = LDS_STAGE + 256, AUXSZ = 6144, LDS_BARW = 8 * 18944, LDS_BYTES = LDS_BARW + 256;
static_assert((size_t)RSPLIT * DFF * 2 <= DYN_SIZE, "act split");
static_assert(SZ_Z + SZ_ROWS <= DYN_SIZE, "ab layer");

struct Params {
    const float* in[32];
    float* out;
    unsigned char* ws;
    int ph_lo, ph_hi;
    int rep_ph, rep_n;
};

typedef __bf16 bf16v2 __attribute__((ext_vector_type(2)));
typedef float f32v2 __attribute__((ext_vector_type(2)));
__device__ __forceinline__ unsigned pack2(float lo, float hi) { const f32v2 f = {lo, hi}; const bf16v2 v = __builtin_convertvector(f, bf16v2); return __builtin_bit_cast(unsigned, v); }
__device__ __forceinline__ bf16_t f2bf(float f) { return (bf16_t)(pack2(f, 0.f) & 0xffffu); }
__device__ __forceinline__ float bf2f(bf16_t b) { return __uint_as_float(((unsigned)b) << 16); }
__device__ __forceinline__ float bflo(unsigned w) { return __uint_as_float(w << 16); }
__device__ __forceinline__ float bfhi(unsigned w) { return __uint_as_float(w & 0xffff0000u); }
__device__ __forceinline__ float fsigmoid(float x) { return __builtin_amdgcn_rcpf(1.0f + __expf(-x)); }
__device__ __forceinline__ float gelu_t(float x) { const float z = 1.5957691216f * (x + 0.044715f * x * x * x); return x * __builtin_amdgcn_rcpf(1.0f + __expf(-z)); }
__device__ __forceinline__ float dpp_shr1(float v) { return __int_as_float(__builtin_amdgcn_update_dpp(__float_as_int(v), __float_as_int(v), 0x111, 0xf, 0xf, false)); }
__device__ __forceinline__ float dpp_shl1(float v) { return __int_as_float(__builtin_amdgcn_update_dpp(__float_as_int(v), __float_as_int(v), 0x101, 0xf, 0xf, false)); }
__device__ __forceinline__ void seq_info(int s, int& rb, int& L) { if (s < 16) { rb = s * LP; L = LP; } else { rb = RP + (s - 16) * LS; L = LS; } }
__device__ __forceinline__ void row_pos(int r, int& pos, int& len) { if (r < RP) { pos = r % LP; len = LP; } else { pos = (r - RP) % LS; len = LS; } }
__device__ __forceinline__ float rowscale(const float* rss, int row) {
    const f32x4* p = (const f32x4*)(rss + (size_t)row * 16);
    const f32x4 a = p[0], b = p[1], c = p[2], d = p[3];
    const float s = ((a[0] + a[1]) + (a[2] + a[3])) + ((b[0] + b[1]) + (b[2] + b[3])) + ((c[0] + c[1]) + (c[2] + c[3])) + ((d[0] + d[1]) + (d[2] + d[3]));
    return rsqrtf(s * (1.0f / 1024.0f) + EPS);
}

namespace pg8 {
constexpr int BM = 256, BK = 64, HALF = 128, HTB = HALF * BK * 2, NXCD = 8, WGM = 8;
__device__ __forceinline__ int lds_byte(int r, int c) { const int st = (r >> 4) * 2 + (c >> 5), rr = r & 15, cc = c & 31, ob = rr * 64 + cc * 2; return st * 1024 + (ob ^ (((ob >> 9) & 1) << 5)); }
__device__ __forceinline__ void stage_rc(int b, int& Rr, int& C) { const int st = b / 1024, sb = b % 1024, swz = sb ^ (((sb >> 9) & 1) << 5); Rr = (st >> 1) * 16 + swz / 64; C = (st & 1) * 32 + (swz % 64) / 2; }
__device__ __forceinline__ int perm32(int rho) { const int n = rho >> 4, i = rho & 15; return 8 * (i >> 2) + 4 * n + (i & 3); }
struct Unit { int pm, pn; };
struct StaticOrder {
    int nM, nN, nwg, G, c;
    __device__ void init(int nM_, int nN_, int G_, int c_) { nM = nM_; nN = nN_; nwg = nM * nN; G = G_; c = c_; }
    __device__ bool next(int i, Unit& u) const {
        const long L = (long)i * G + c; if (L >= nwg) return false;
        int wgid = (int)L; { const int q = nwg / NXCD, r = nwg % NXCD, xcd = wgid % NXCD, off = wgid / NXCD; wgid = (xcd < r ? xcd * (q + 1) : r * (q + 1) + (xcd - r) * q) + off; }
        const int nig = WGM * nN, gid = wgid / nig, fm = gid * WGM, gsz = (nM - fm) < WGM ? (nM - fm) : WGM;
        u.pm = fm + ((wgid % nig) % gsz); u.pn = (wgid % nig) / gsz; return true;
    }
};
struct GemmDesc { const char* A; const char* A2; int pm_split; int lda; const char* Bt; int K; int ablk; };

template <bool CONV, class Epi>
__device__ __forceinline__ void gemm_phase(LAS unsigned char* lds, const GemmDesc g, const StaticOrder& S, const Epi& E) {
    int tid = threadIdx.x; asm volatile("" : "+v"(tid));
    const int wid = __builtin_amdgcn_readfirstlane(tid >> 6), lane = tid & 63, wr = wid >> 2, wc = wid & 3, fr = lane & 15, fq = lane >> 4;
    const int K = g.K, nt = K / BK;
    int voffA[2], voffB[2];
#pragma unroll
    for (int i = 0; i < 2; ++i) { int Rr, C; stage_rc(tid * 16 + i * 8192, Rr, C);
        const int ra = CONV ? (62 * (Rr >> 6) - 1 + 4 * (Rr & 15) + ((Rr >> 4) & 3)) : Rr;
        const int Rb = Epi::WIDE ? ((Rr >> 5) * 64 + ((Rr >> 2) & 3) * 16 + ((Rr >> 4) & 1) * 4 + (Rr & 3)) : ((Rr & ~31) + perm32(Rr & 31));
        voffA[i] = g.ablk ? (((C >> 4) * MP + ra) * 16 + (C & 15)) * 2 : (ra * g.lda + C) * 2; voffB[i] = (Rb * K + C) * 2; }
    const long kstep = (long)(BK * 2);
    const long kstepA = g.ablk ? 4L * MP * 32 : kstep;
    const long hstepA = g.ablk ? (long)HALF * 32 : (long)(CONV ? 124 : HALF) * g.lda * 2, tstepA = 2 * hstepA;
    const long hstepB = (long)(Epi::WIDE ? 8 : HALF) * K * 2, tstepB = 2L * HALF * K * 2;
    const unsigned ldsw = (unsigned)wid * 1024u;
    const int aoff = lds_byte(wr * 64 + fr, fq * 8), boff = lds_byte(wc * 32 + fr, fq * 8);
#define PG8_SA(b, h) (((b) * 2 + (h)) * HTB)
#define PG8_SB(b, h) ((4 + (b) * 2 + (h)) * HTB)
#define PG8_STAGE(bufoff, gbase, voff) do { _Pragma("unroll") for (int _i = 0; _i < 2; ++_i) \
        __builtin_amdgcn_global_load_lds((const unsigned*)((const char*)(gbase) + (voff)[_i]), (LAS unsigned*)(lds + (bufoff) + ldsw + _i * 8192), 16, 0, 0); } while (0)
#define PG8_LDA(dst, b, h) do { _Pragma("unroll") for (int m = 0; m < 4; ++m) _Pragma("unroll") for (int k = 0; k < 2; ++k) dst[m][k] = *(const LAS bf16x8*)(lds + PG8_SA(b, h) + aoff + m * 2048 + k * 1024); } while (0)
#define PG8_LDB(dst, b, h) do { _Pragma("unroll") for (int n = 0; n < 2; ++n) _Pragma("unroll") for (int k = 0; k < 2; ++k) dst[n][k] = *(const LAS bf16x8*)(lds + PG8_SB(b, h) + boff + n * 2048 + k * 1024); } while (0)
#define PG8_MMA(ai, bj, At, Bt) do { __builtin_amdgcn_s_setprio(1); _Pragma("unroll") for (int m = 0; m < 4; ++m) _Pragma("unroll") for (int n = 0; n < 2; ++n) _Pragma("unroll") for (int k = 0; k < 2; ++k) \
        acc[ai][bj][m][n] = __builtin_amdgcn_mfma_f32_16x16x32_bf16(Bt[n][k], At[m][k], acc[ai][bj][m][n], 0, 0, 0); __builtin_amdgcn_s_setprio(0); } while (0)
#define PG8_WAIT_V(n) asm volatile("s_waitcnt vmcnt(" #n ")" ::: "memory")
#define PG8_WAIT_L(n) asm volatile("s_waitcnt lgkmcnt(" #n ")" ::: "memory")
#define PG8_BAR __builtin_amdgcn_s_barrier()
#define PG8_SCHED __builtin_amdgcn_sched_barrier(0)
#define PG8_ABASE(pm) ((pm) < g.pm_split ? g.A + (long)(pm) * tstepA : g.A2 + (long)((pm) - g.pm_split) * tstepA)
    Unit cur, nxt; int ui = 0;
    if (!S.next(0, cur)) return;
    f32x4 acc[2][2][4][2];
#pragma unroll
    for (int a = 0; a < 2; ++a)
#pragma unroll
        for (int b = 0; b < 2; ++b)
#pragma unroll
            for (int m = 0; m < 4; ++m)
#pragma unroll
                for (int n = 0; n < 2; ++n) acc[a][b][m][n] = (f32x4){0.f, 0.f, 0.f, 0.f};
    bf16x8 At[4][2], B0[2][2], B1[2][2];
    const char* cA = PG8_ABASE(cur.pm); const char* cB = g.Bt + (long)cur.pn * tstepB;
    PG8_STAGE(PG8_SB(0, 0), cB, voffB); PG8_STAGE(PG8_SA(0, 0), cA, voffA); PG8_STAGE(PG8_SB(0, 1), cB + hstepB, voffB); PG8_STAGE(PG8_SA(0, 1), cA + hstepA, voffA);
    if (wr == 1) PG8_BAR;
    PG8_WAIT_V(4); PG8_BAR;
    PG8_STAGE(PG8_SB(1, 0), cB + kstep, voffB); PG8_STAGE(PG8_SA(1, 0), cA + kstepA, voffA); PG8_STAGE(PG8_SB(1, 1), cB + hstepB + kstep, voffB);
    PG8_WAIT_V(6); PG8_BAR;
    for (;;) {
        const bool has_next = S.next(ui + 1, nxt);
        const char* nA = has_next ? PG8_ABASE(nxt.pm) : cA; const char* nB = has_next ? g.Bt + (long)nxt.pn * tstepB : cB;
        LAS unsigned char* aux = lds + AUX_OFF + (ui & 1) * AUXSZ;
        E.prefetch(aux, cur, tid);
        for (int t = 0; t < nt; t += 2) {
            const bool last = (t == nt - 2);
            const char* a1 = cA + (long)(t + 1) * kstepA;
            const char* a2 = last ? nA : cA + (long)(t + 2) * kstepA; const char* b2 = last ? nB : cB + (long)(t + 2) * kstep;
            const char* a3 = a2 + kstepA; const char* b3 = b2 + kstep;
            PG8_LDB(B0, 0, 0); PG8_SCHED; PG8_LDA(At, 0, 0); PG8_STAGE(PG8_SA(1, 1), a1 + hstepA, voffA);
            PG8_WAIT_L(8); PG8_BAR; PG8_WAIT_L(0); PG8_MMA(0, 0, At, B0); PG8_BAR; PG8_SCHED;
            PG8_LDB(B1, 0, 1); PG8_STAGE(PG8_SB(0, 0), b2, voffB);
            PG8_BAR; PG8_WAIT_L(0); PG8_MMA(0, 1, At, B1); PG8_BAR;
            PG8_LDA(At, 0, 1); PG8_STAGE(PG8_SA(0, 0), a2, voffA);
            PG8_BAR; PG8_WAIT_L(0); PG8_MMA(1, 0, At, B0); PG8_BAR; PG8_SCHED;
            PG8_STAGE(PG8_SB(0, 1), b2 + hstepB, voffB);
            PG8_WAIT_V(6); PG8_BAR; PG8_MMA(1, 1, At, B1); PG8_BAR;
            PG8_LDB(B0, 1, 0); PG8_SCHED; PG8_LDA(At, 1, 0); PG8_STAGE(PG8_SA(0, 1), a2 + hstepA, voffA);
            PG8_WAIT_L(8); PG8_BAR; PG8_WAIT_L(0); PG8_MMA(0, 0, At, B0); PG8_BAR; PG8_SCHED;
            PG8_LDB(B1, 1, 1); PG8_STAGE(PG8_SB(1, 0), b3, voffB);
            PG8_BAR; PG8_WAIT_L(0); PG8_MMA(0, 1, At, B1); PG8_BAR;
            PG8_LDA(At, 1, 1); PG8_STAGE(PG8_SA(1, 0), a3, voffA);
            PG8_BAR; PG8_WAIT_L(0); PG8_MMA(1, 0, At, B0); PG8_BAR; PG8_SCHED;
            PG8_STAGE(PG8_SB(1, 1), b3 + hstepB, voffB);
            PG8_WAIT_V(6); PG8_BAR; PG8_MMA(1, 1, At, B1); PG8_BAR;
        }
        E(acc, cur, wr, wc, fr, fq, aux);
        if (!has_next) break;
#pragma unroll
        for (int a = 0; a < 2; ++a)
#pragma unroll
            for (int b = 0; b < 2; ++b)
#pragma unroll
                for (int m = 0; m < 4; ++m)
#pragma unroll
                    for (int n = 0; n < 2; ++n) acc[a][b][m][n] = (f32x4){0.f, 0.f, 0.f, 0.f};
        cur = nxt; cA = nA; cB = nB; ++ui;
    }
    PG8_WAIT_V(0);
    if (wr == 0) PG8_BAR;
    PG8_BAR;
#undef PG8_SA
#undef PG8_SB
#undef PG8_STAGE
#undef PG8_LDA
#undef PG8_LDB
#undef PG8_MMA
#undef PG8_WAIT_V
#undef PG8_WAIT_L
#undef PG8_BAR
#undef PG8_SCHED
#undef PG8_ABASE
}
}

typedef f32x4 AccT[2][2][4][2];

struct EpiScale {
    static constexpr bool WIDE = true;
    bf16_t* out; int ldc; const float* rss; bf16_t* vt; int vt_pn; bf16_t* kt;
    __device__ __forceinline__ void prefetch(LAS unsigned char* aux, const pg8::Unit& u, int tid) const {
        if (tid < 256) ((LAS float*)aux)[tid] = rowscale(rss, u.pm * 256 + tid);
    }
    __device__ __forceinline__ void operator()(AccT& acc, const pg8::Unit& u, int wr, int wc, int fr, int fq, LAS unsigned char* aux) const {
#pragma unroll
        for (int ai = 0; ai < 2; ++ai)
#pragma unroll
            for (int m = 0; m < 4; ++m) {
                const int rl = ai * 128 + wr * 64 + m * 16 + fr, row = u.pm * 256 + rl;
                const float rs = ((const LAS float*)aux)[rl];
                if (u.pn < vt_pn - 1) {
#pragma unroll
                    for (int bj = 0; bj < 2; ++bj) { const int col = u.pn * 256 + wc * 64 + 16 * fq + 8 * bj; const f32x4 v0 = acc[ai][bj][m][0] * rs, v1 = acc[ai][bj][m][1] * rs;
                        u32x4 w; w.x = pack2(v0[0], v0[1]); w.y = pack2(v0[2], v0[3]); w.z = pack2(v1[0], v1[1]); w.w = pack2(v1[2], v1[3]); __builtin_nontemporal_store(w, (u32x4*)(out + (size_t)row * ldc + col)); }
                } else if (u.pn == vt_pn - 1) {
#pragma unroll
                    for (int bj = 0; bj < 2; ++bj) { const int dt_ = wc * 64 + 16 * fq + 8 * bj; const f32x4 v0 = acc[ai][bj][m][0] * rs, v1 = acc[ai][bj][m][1] * rs;
                        u32x4 w; w.x = pack2(v0[0], v0[1]); w.y = pack2(v0[2], v0[3]); w.z = pack2(v1[0], v1[1]); w.w = pack2(v1[2], v1[3]);
                        *(u32x4*)(kt + ((((size_t)(dt_ >> 6) * (MP / 16) + (row >> 4)) * 4 + ((dt_ & 63) >> 4)) * 16 + (row & 15)) * 16 + (dt_ & 8)) = w; }
                } else {
#pragma unroll
                    for (int bj = 0; bj < 2; ++bj)
#pragma unroll
                        for (int n = 0; n < 2; ++n) { const int d = (u.pn - vt_pn) * 256 + wc * 64 + 16 * fq + 8 * bj + 4 * n; const f32x4 v = acc[ai][bj][m][n] * rs;
#pragma unroll
                            for (int e = 0; e < 4; ++e) { const int dt_ = d + e; vt[((size_t)((dt_ >> 6) * (MP / 16) + (row >> 4)) * 64 + (dt_ & 63)) * 16 + (row & 15)] = f2bf(v[e]); } }
                }
            }
    }
};

struct EpiGlu {
    static constexpr bool WIDE = true;
    const bf16_t* yin; bf16_t* out; const float* bias;
    __device__ __forceinline__ void prefetch(LAS unsigned char*, const pg8::Unit&, int) const {}
    __device__ __forceinline__ void operator()(AccT& acc, const pg8::Unit& u, int wr, int wc, int fr, int fq, LAS unsigned char*) const {
#pragma unroll
        for (int ai = 0; ai < 2; ++ai)
#pragma unroll
            for (int m = 0; m < 4; ++m) {
                const int row = u.pm * 256 + ai * 128 + wr * 64 + m * 16 + fr;
#pragma unroll
                for (int bj = 0; bj < 2; ++bj) { const int col = u.pn * 256 + wc * 64 + 16 * fq + 8 * bj;
                    const size_t boff = ((size_t)(col >> 4) * MP + row) * 16 + (col & 15);
                    const u32x4 yw = *(const u32x4*)(yin + boff); const f32x4 b0 = *(const f32x4*)(bias + col), b1 = *(const f32x4*)(bias + col + 4);
                    const f32x4 a0 = acc[ai][bj][m][0], a1 = acc[ai][bj][m][1];
                    u32x4 w;
                    w.x = pack2(bflo(yw.x) * fsigmoid(a0[0] + b0[0]), bfhi(yw.x) * fsigmoid(a0[1] + b0[1])); w.y = pack2(bflo(yw.y) * fsigmoid(a0[2] + b0[2]), bfhi(yw.y) * fsigmoid(a0[3] + b0[3]));
                    w.z = pack2(bflo(yw.z) * fsigmoid(a1[0] + b1[0]), bfhi(yw.z) * fsigmoid(a1[1] + b1[1])); w.w = pack2(bflo(yw.w) * fsigmoid(a1[2] + b1[2]), bfhi(yw.w) * fsigmoid(a1[3] + b1[3]));
                    __builtin_nontemporal_store(w, (u32x4*)(out + boff)); }
            }
    }
};

struct EpiRes {
    static constexpr bool WIDE = true;
    bf16_t* H; float* rss; int compact;
    __device__ __forceinline__ void prefetch(LAS unsigned char*, const pg8::Unit&, int) const {}
    __device__ __forceinline__ void operator()(AccT& acc, const pg8::Unit& u, int wr, int wc, int fr, int fq, LAS unsigned char*) const {
#pragma unroll
        for (int ai = 0; ai < 2; ++ai)
#pragma unroll
            for (int m = 0; m < 4; ++m) {
                int row = u.pm * 256 + ai * 128 + wr * 64 + m * 16 + fr; float ss = 0.f;
                if (compact) row = (row < 32768) ? row + 16 * ((row >> 11) + 1) : row + 16 * (17 + ((row - 32768) >> 13));
#pragma unroll
                for (int bj = 0; bj < 2; ++bj) { const int col = u.pn * 256 + wc * 64 + 16 * fq + 8 * bj; bf16_t* hp = H + (size_t)row * 1024 + col;
                    const u32x4 hw = *(const u32x4*)hp; const f32x4 a0 = acc[ai][bj][m][0], a1 = acc[ai][bj][m][1];
                    const float v0 = bflo(hw.x) + a0[0], v1 = bfhi(hw.x) + a0[1], v2 = bflo(hw.y) + a0[2], v3 = bfhi(hw.y) + a0[3];
                    const float v4 = bflo(hw.z) + a1[0], v5 = bfhi(hw.z) + a1[1], v6 = bflo(hw.w) + a1[2], v7 = bfhi(hw.w) + a1[3];
                    ss += ((v0 * v0 + v1 * v1) + (v2 * v2 + v3 * v3)) + ((v4 * v4 + v5 * v5) + (v6 * v6 + v7 * v7));
                    u32x4 w; w.x = pack2(v0, v1); w.y = pack2(v2, v3); w.z = pack2(v4, v5); w.w = pack2(v6, v7); __builtin_nontemporal_store(w, (u32x4*)hp); }
                ss += __shfl_xor(ss, 16); ss += __shfl_xor(ss, 32);
                if (fq == 0) rss[(size_t)row * 16 + u.pn * 4 + wc] = ss;
            }
    }
};

struct EpiUp {
    static constexpr bool WIDE = false;
    bf16_t* act1; bf16_t* act2; const float* rss; const float* cw; const float* cb; int compact;
    __device__ __forceinline__ void prefetch(LAS unsigned char* aux, const pg8::Unit& u, int tid) const {
        if (tid < 256) {
            const int t = u.pm * 248 + 62 * (tid >> 6) - 1 + 4 * (tid & 15) + ((tid >> 4) & 3);
            const int tc = t < 0 ? 0 : (t > MP - 1 ? MP - 1 : t);
            int pos, len; row_pos(tc, pos, len);
            ((LAS float*)aux)[tid] = rowscale(rss, tc);
            ((LAS unsigned*)aux)[256 + tid] = (pos == 0 ? 1u : 0u) | (pos == len - 1 ? 2u : 0u);
        } else {
            const int tt = tid - 256, kind = tt >> 5, c4 = (tt & 31) * 4, k3 = kind & 3;
            const float* srcp = (k3 == 3 ? cb : cw + k3 * 5632) + (kind >= 4 ? DFF : 0) + u.pn * 128 + c4;
            *(LAS f32x4*)(aux + 2048 + (kind * 128 + c4) * 4) = *(const f32x4*)srcp;
        }
    }
    __device__ __forceinline__ void operator()(AccT& acc, const pg8::Unit& u, int wr, int wc, int fr, int fq, LAS unsigned char* aux) const {
        float rs[2][4]; unsigned fl = 0;
#pragma unroll
        for (int ai = 0; ai < 2; ++ai)
#pragma unroll
            for (int m = 0; m < 4; ++m) { const int rl = ai * 128 + wr * 64 + m * 16 + fr; rs[ai][m] = ((const LAS float*)aux)[rl]; fl |= ((const LAS unsigned*)aux)[256 + rl] << ((ai * 4 + m) * 2); }
        const LAS float* cv = (const LAS float*)(aux + 2048);
#pragma unroll
        for (int n = 0; n < 2; ++n) {
            const int cl = wc * 32 + 8 * fq + 4 * n;
            const f32x4 wa0 = *(const LAS f32x4*)(cv + cl), wa1 = *(const LAS f32x4*)(cv + 128 + cl), wa2 = *(const LAS f32x4*)(cv + 256 + cl), ba = *(const LAS f32x4*)(cv + 384 + cl);
            const f32x4 wg0 = *(const LAS f32x4*)(cv + 512 + cl), wg1 = *(const LAS f32x4*)(cv + 640 + cl), wg2 = *(const LAS f32x4*)(cv + 768 + cl), bg = *(const LAS f32x4*)(cv + 896 + cl);
#pragma unroll
            for (int e2 = 0; e2 < 2; ++e2) {
                const int e0 = 2 * e2, e1 = e0 + 1;
                const f32v2 pwa0 = {wa0[e0], wa0[e1]}, pwa1 = {wa1[e0], wa1[e1]}, pwa2 = {wa2[e0], wa2[e1]}, pba = {ba[e0], ba[e1]};
                const f32v2 pwg0 = {wg0[e0], wg0[e1]}, pwg1 = {wg1[e0], wg1[e1]}, pwg2 = {wg2[e0], wg2[e1]}, pbg = {bg[e0], bg[e1]};
#pragma unroll
                for (int ai = 0; ai < 2; ++ai) {
                    f32v2 ua[4], ug[4];
#pragma unroll
                    for (int m = 0; m < 4; ++m) { const f32v2 a2 = {acc[ai][0][m][n][e0], acc[ai][0][m][n][e1]}, g2 = {acc[ai][1][m][n][e0], acc[ai][1][m][n][e1]}; ua[m] = a2 * rs[ai][m]; ug[m] = g2 * rs[ai][m]; }
                    const f32v2 pa = {dpp_shr1(ua[3].x), dpp_shr1(ua[3].y)}, pg = {dpp_shr1(ug[3].x), dpp_shr1(ug[3].y)};
                    const f32v2 na = {dpp_shl1(ua[0].x), dpp_shl1(ua[0].y)}, ng = {dpp_shl1(ug[0].x), dpp_shl1(ug[0].y)};
#pragma unroll
                    for (int m = 0; m < 4; ++m) {
                        const bool first = (fl >> ((ai * 4 + m) * 2)) & 1u, lastt = (fl >> ((ai * 4 + m) * 2 + 1)) & 1u;
                        f32v2 a_p = (m == 0) ? pa : ua[m == 0 ? 0 : m - 1], g_p = (m == 0) ? pg : ug[m == 0 ? 0 : m - 1];
                        f32v2 a_n = (m == 3) ? na : ua[m == 3 ? 3 : m + 1], g_n = (m == 3) ? ng : ug[m == 3 ? 3 : m + 1];
                        const f32v2 zz = {0.f, 0.f};
                        if (first) { a_p = zz; g_p = zz; }
                        if (lastt) { a_n = zz; g_n = zz; }
                        const f32v2 av = pwa0 * a_p + pwa1 * ua[m] + pwa2 * a_n + pba;
                        const f32v2 gv = pwg0 * g_p + pwg1 * ug[m] + pwg2 * g_n + pbg;
                        const f32v2 zexp = gv * (gv * gv * (-0.102943185f) + (-2.302208198f));
                        f32v2 den; den.x = 1.0f + __builtin_amdgcn_exp2f(zexp.x); den.y = 1.0f + __builtin_amdgcn_exp2f(zexp.y);
                        f32v2 sg; sg.x = __builtin_amdgcn_rcpf(den.x); sg.y = __builtin_amdgcn_rcpf(den.y);
                        f32v2 res = gv * sg * av; asm volatile("" : "+v"(res));
                        acc[ai][0][m][n][e0] = res.x; acc[ai][0][m][n][e1] = res.y;
                    }
                }
                __builtin_amdgcn_sched_barrier(0);
            }
        }
#pragma unroll
        for (int ai = 0; ai < 2; ++ai)
#pragma unroll
            for (int m = 0; m < 4; ++m) {
                const int i = 4 * fr + m; const int t = u.pm * 248 + 62 * (2 * ai + wr) - 1 + i;
                bool ok = (i >= 1 && i <= 62 && t < R); int tr = t;
                if (compact && ok) { int pos, sidx; if (t < RP) { sidx = t / LP; pos = t - sidx * LP; } else { const int t2 = t - RP; const int s2 = t2 / LS; pos = t2 - s2 * LS; sidx = 16 + s2; }
                    ok = (pos >= 16); tr = t - 16 * (sidx + 1); }
                if (ok) {
                    bf16_t* rowp = (tr < RSPLIT) ? act1 + (size_t)tr * DFF : act2 + (size_t)(tr - RSPLIT) * DFF;
                    const f32x4 v0 = acc[ai][0][m][0], v1 = acc[ai][0][m][1];
                    u32x4 w; w.x = pack2(v0[0], v0[1]); w.y = pack2(v0[2], v0[3]); w.z = pack2(v1[0], v1[1]); w.w = pack2(v1[2], v1[3]);
                    __builtin_nontemporal_store(w, (u32x4*)(rowp + u.pn * 128 + wc * 32 + 8 * fq));
                }
            }
    }
};

__device__ __forceinline__ const float* src_row(const Params& p, int r) {
    if (r < RP) { const int s = r / LP, pos = r - s * LP; return pos < 16 ? p.in[2] + pos * DM : p.in[0] + ((size_t)s * 2048 + pos - 16) * DM; }
    const int r2 = r - RP, s = r2 / LS, pos = r2 - s * LS; return pos < 16 ? p.in[2] + pos * DM : p.in[1] + ((size_t)s * 8192 + pos - 16) * DM;
}
__device__ __forceinline__ void cvt_w(bf16_t* dst, const float* src, int K, int N, const float* gk, int nscale_lim, bool upperm, long t0, long nth) {
    const long total = (long)N * (K / 8);
    for (long t = t0; t < total; t += nth) {
        const int n = (int)(t % N), kb = (int)(t / N);
        const int sn = upperm ? (((n & 255) < 128) ? (n >> 8) * 128 + (n & 127) : DFF + (n >> 8) * 128 + (n & 127)) : n;
        const float sc = n < nscale_lim ? 0.125f * 1.4426950408889634f : 1.0f;
        float v[8];
#pragma unroll
        for (int j = 0; j < 8; ++j) { const int k = kb * 8 + j; v[j] = src[(size_t)k * N + sn] * (gk ? gk[k] : 1.0f) * sc; }
        u32x4 w; w.x = pack2(v[0], v[1]); w.y = pack2(v[2], v[3]); w.z = pack2(v[4], v[5]); w.w = pack2(v[6], v[7]);
        *(u32x4*)(dst + (size_t)n * K + kb * 8) = w;
    }
}
__device__ __forceinline__ void phase_prep(const Params& p) {
    int tid = threadIdx.x; asm volatile("" : "+v"(tid)); const int lane = tid & 63, wid = tid >> 6;
    const int gw = blockIdx.x * 8 + wid, nw = gridDim.x * 8;
    bf16_t* H = (bf16_t*)(p.ws + OFF_HPAD) + 8 * 1024; float* rss = (float*)(p.ws + OFF_RSS);
    for (int rr0 = gw; rr0 < MP + 8; rr0 += 2 * nw) {
        f32x4 v[2][4]; bool ok[2]; int rws[2];
#pragma unroll
        for (int j = 0; j < 2; ++j) {
            const int rr = rr0 + j * nw; const int r = rr - 8; rws[j] = r;
            ok[j] = (rr < MP + 8) && (r >= 0) && (r < R);
            if (ok[j]) { const float* src = src_row(p, r);
#pragma unroll
                for (int i = 0; i < 4; ++i) v[j][i] = *(const f32x4*)(src + i * 256 + lane * 4); }
            else {
#pragma unroll
                for (int i = 0; i < 4; ++i) v[j][i] = (f32x4){0.f, 0.f, 0.f, 0.f}; }
        }
#pragma unroll
        for (int j = 0; j < 2; ++j) {
            const int rr = rr0 + j * nw; if (rr >= MP + 8) continue;
            const int r = rws[j]; bf16_t* hrow = H + (long)r * 1024; float ss = 0.f;
#pragma unroll
            for (int i = 0; i < 4; ++i) { const f32x4 x = v[j][i]; ss += (x[0] * x[0] + x[1] * x[1]) + (x[2] * x[2] + x[3] * x[3]);
                u32x2 w; w.x = pack2(x[0], x[1]); w.y = pack2(x[2], x[3]); *(u32x2*)(hrow + i * 256 + lane * 4) = w; }
#pragma unroll
            for (int o = 32; o >= 1; o >>= 1) ss += __shfl_xor(ss, o);
            if (r >= 0 && lane < 16) rss[(size_t)r * 16 + lane] = (lane == 0) ? ss : 0.f;
        }
    }
    unsigned char* ws = p.ws;
    cvt_w((bf16_t*)(ws + OFF_WIN), p.in[6], 1024, 1536, p.in[3], 0, false, (long)blockIdx.x * blockDim.x + tid, (long)gridDim.x * blockDim.x);
}
__device__ __forceinline__ void cvt_rest(const Params& p, long t0, long nth) {
    unsigned char* ws = p.ws;
    cvt_w((bf16_t*)(ws + OFF_WGLU), p.in[15], 512, 512, nullptr, 0, false, t0, nth);
    cvt_w((bf16_t*)(ws + OFF_WOUT), p.in[24], 1024, 1024, nullptr, 0, false, t0, nth);
    cvt_w((bf16_t*)(ws + OFF_WUP0), p.in[28], 1024, 5632, p.in[4], 0, true, t0, nth);
    cvt_w((bf16_t*)(ws + OFF_WDN0), p.in[31], 2816, 1024, nullptr, 0, false, t0, nth);
    cvt_w((bf16_t*)(ws + OFF_WQKV), p.in[25], 1024, 1536, p.in[3] + 1024, 1024, false, t0, nth);
    cvt_w((bf16_t*)(ws + OFF_WO), p.in[26], 1024, 1024, nullptr, 0, false, t0, nth);
    cvt_w((bf16_t*)(ws + OFF_WUP1), p.in[28] + (size_t)1024 * 5632, 1024, 5632, p.in[4] + 1024, 0, true, t0, nth);
    cvt_w((bf16_t*)(ws + OFF_WDN1), p.in[31] + (size_t)2816 * 1024, 2816, 1024, nullptr, 0, false, t0, nth);
}

constexpr int WLDS = 18944;
__device__ __forceinline__ void s5_unit(const Params& p, LAS unsigned char* wl, int s, int d, int g, int lane, const bf16_t* Z, bf16_t* outb) {
    asm volatile("" : "+v"(lane));
    int rb, L; seq_info(s, rb, L);
    const int col = lane & 15, q = lane >> 4, dg = d * 32 + g;
    const float* lam_re = p.in[7]; const float* lam_im = p.in[8]; const float* b_re = p.in[10]; const float* b_im = p.in[11]; const float* c_re = p.in[12]; const float* c_im = p.in[13];
    const float dt = expf(p.in[9][dg]);
    float lbr, lbi;
    { const float lr = fminf(lam_re[dg * 64 + lane], -1e-4f), li = lam_im[dg * 64 + lane]; const float a = lr * dt, b = li * dt, e = expf(a); float sb, cb; sincosf(b, &sb, &cb); lbr = e * cb; lbi = e * sb; }
    bf16x4 Bf[8]; bf16x8 Cf[4];
#pragma unroll
    for (int i = 0; i < 8; ++i) {
        const int kp = 16 * i + col, n = kp & 63, part = kp >> 6;
        const float lr = fminf(lam_re[dg * 64 + n], -1e-4f), li = lam_im[dg * 64 + n]; const float a = lr * dt, b = li * dt, e = expf(a); float sb, cb; sincosf(b, &sb, &cb);
        const float sh = sinf(0.5f * b); const float nr = expm1f(a) * cb - 2.0f * sh * sh, ni = e * sb; const float inv = 1.0f / (lr * lr + li * li);
        const float cr = (nr * lr + ni * li) * inv, ci = (ni * lr - nr * li) * inv;
#pragma unroll
        for (int j = 0; j < 4; ++j) {
            const int c = 4 * q + j; const float bre = b_re[(size_t)(dg * 64 + n) * 16 + c], bim = b_im[(size_t)(dg * 64 + n) * 16 + c];
            Bf[i][j] = (short)f2bf((part == 0) ? cr * bre - ci * bim : cr * bim + ci * bre);
        }
    }
#pragma unroll
    for (int kk = 0; kk < 4; ++kk)
#pragma unroll
        for (int j = 0; j < 8; ++j) { const int kp = 32 * kk + 8 * q + j, n = kp >> 1; const float val = (kp & 1) ? -c_im[(size_t)(dg * 16 + col) * 64 + n] : c_re[(size_t)(dg * 16 + col) * 64 + n]; Cf[kk][j] = (short)f2bf(val); }
    LAS float* BUt = (LAS float*)wl;
    LAS bf16_t* Xb = (LAS bf16_t*)(wl + 10240);
    float xr = 0.f, xi = 0.f;
    const int nch = L / 16;
    const bf16x4 zero4 = {0, 0, 0, 0};
    const bf16_t* zg = Z + (size_t)rb * 1536 + 16 * g + 4 * q;
#define S5_FRAG(dst, CH) do { dst = zero4; if ((CH) < nch) { const int _tau = (CH) * 16 + col; dst = *(const bf16x4*)(zg + (size_t)(d ? (L - 1 - _tau) : _tau) * 1536); } } while (0)
#define S5_CPROJ(CH) do { const LAS bf16_t* _X = Xb + ((CH) & 1) * 2176; f32x4 y = {0.f, 0.f, 0.f, 0.f}; \
        _Pragma("unroll") for (int kk = 0; kk < 4; ++kk) { const bf16x8 xa = *(const LAS bf16x8*)(_X + col * 136 + 32 * kk + 8 * q); y = __builtin_amdgcn_mfma_f32_16x16x32_bf16(xa, Cf[kk], y, 0, 0, 0); } \
        _Pragma("unroll") for (int r = 0; r < 4; ++r) { const int tau = (CH) * 16 + 4 * q + r; const int pos = d ? (L - 1 - tau) : tau; outb[((size_t)g * MP + rb + pos) * 16 + col] = f2bf(y[r]); } } while (0)
    bf16x4 ring[3];
    { bf16x4 a0; S5_FRAG(a0, 0);
#pragma unroll
      for (int i = 0; i < 8; ++i) { const f32x4 bu = __builtin_amdgcn_mfma_f32_16x16x16bf16_1k(a0, Bf[i], (f32x4){0.f, 0.f, 0.f, 0.f}, 0, 0, 0); *(LAS f32x4*)(BUt + (16 * i + col) * 20 + 4 * q) = bu; }
      S5_FRAG(ring[1], 1); S5_FRAG(ring[2], 2); S5_FRAG(ring[0], 3); }
    asm volatile("s_waitcnt lgkmcnt(0)" ::: "memory");
    for (int ch3 = 0; ch3 < nch; ch3 += 3) {
#pragma unroll
      for (int k3 = 0; k3 < 3; ++k3) {
        const int ch = ch3 + k3;
        f32x4 re4[4], im4[4];
#pragma unroll
        for (int v = 0; v < 4; ++v) { re4[v] = *(const LAS f32x4*)(BUt + lane * 20 + 4 * v); im4[v] = *(const LAS f32x4*)(BUt + (64 + lane) * 20 + 4 * v); }
        asm volatile("s_waitcnt lgkmcnt(0)" ::: "memory");
        f32x4 bun[8];
        const bool more = (ch + 1 < nch);
        if (more) {
            const bf16x4 a = ring[(k3 + 1) % 3];
#pragma unroll
            for (int i = 0; i < 8; ++i) bun[i] = __builtin_amdgcn_mfma_f32_16x16x16bf16_1k(a, Bf[i], (f32x4){0.f, 0.f, 0.f, 0.f}, 0, 0, 0);
            S5_FRAG(ring[(k3 + 1) % 3], ch + 4);
        }
        if (ch > 0) S5_CPROJ(ch - 1);
        LAS bf16_t* X = Xb + (ch & 1) * 2176;
#pragma unroll
        for (int t = 0; t < 16; ++t) {
            const float re = re4[t >> 2][t & 3], im = im4[t >> 2][t & 3];
            const float nxr = lbr * xr - lbi * xi + re, nxi = lbr * xi + lbi * xr + im; xr = nxr; xi = nxi;
            *(LAS unsigned*)(X + t * 136 + 2 * lane) = pack2(xr, xi);
        }
        if (more) {
#pragma unroll
            for (int i = 0; i < 8; ++i) *(LAS f32x4*)(BUt + (16 * i + col) * 20 + 4 * q) = bun[i];
        }
        asm volatile("s_waitcnt lgkmcnt(0)" ::: "memory");
      }
    }
    S5_CPROJ(nch - 1);
    asm volatile("s_waitcnt lgkmcnt(0)" ::: "memory");
#undef S5_FRAG
#undef S5_CPROJ
}

__device__ __forceinline__ void lru_unit(const Params& p, LAS unsigned char* wl, int s, int d, int hb, int nt, int lane, const bf16_t* Z, bf16_t* outb) {
    asm volatile("" : "+v"(lane));
    int rb, L; seq_info(s, rb, L);
    const int col = lane & 15, q = lane >> 4;
    const float* cwp = p.in[17]; const float* cbp = p.in[18];
    const float* Wr = p.in[19] + (size_t)(d * 8 + hb) * 4096; const float* Wi = p.in[21] + (size_t)(d * 8 + hb) * 4096;
    const int no = 16 * nt + col, cho = 64 * hb + no;
    float br = p.in[20][d * 512 + cho], bi = p.in[22][d * 512 + cho];
#pragma unroll 4
    for (int k = 0; k < 64; ++k) { const float cbk = cbp[64 * hb + k]; br += cbk * Wr[k * 64 + no]; bi += cbk * Wi[k * 64 + no]; }
    const float sp = log1pf(expf(-p.in[23][d * 512 + cho]));
    const float cw0 = cwp[cho], cw1 = cwp[512 + cho], cw2 = cwp[1024 + cho], cw3 = cwp[1536 + cho], cb0 = cbp[cho];
    bf16x8 WfR[4][2], WfI[4][2];
#pragma unroll
    for (int j = 0; j < 4; ++j)
#pragma unroll
        for (int kk = 0; kk < 2; ++kk) {
            float wr8[8], wi8[8];
#pragma unroll
            for (int e = 0; e < 8; ++e) { const int k = 32 * kk + 8 * q + e; const float c = cwp[j * 512 + 64 * hb + k]; wr8[e] = c * Wr[k * 64 + no]; wi8[e] = c * Wi[k * 64 + no]; }
            u32x4 a, b; a.x = pack2(wr8[0], wr8[1]); a.y = pack2(wr8[2], wr8[3]); a.z = pack2(wr8[4], wr8[5]); a.w = pack2(wr8[6], wr8[7]);
            b.x = pack2(wi8[0], wi8[1]); b.y = pack2(wi8[2], wi8[3]); b.z = pack2(wi8[4], wi8[5]); b.w = pack2(wi8[6], wi8[7]);
            WfR[j][kk] = __builtin_bit_cast(bf16x8, a); WfI[j][kk] = __builtin_bit_cast(bf16x8, b);
        }
    float carry = 0.f;
    const int nch = L / 16;
    const bf16_t* zrow = Z + (size_t)rb * 1536 + 512 + 64 * hb;
#define LRU_LOAD(dst, CH) do { const int _plo = d ? (L - 16 - 16 * (CH)) : 16 * (CH); \
        _Pragma("unroll") for (int i = 0; i < 3; ++i) { const int pc = lane + 64 * i; const int pp = _plo - 2 + (pc >> 3); u32x4 v = {0u, 0u, 0u, 0u}; \
            if ((CH) < nch && pc < 152 && pp >= 0 && pp < L) v = *(const u32x4*)(zrow + (size_t)pp * 1536 + (pc & 7) * 8); dst[i] = v; } } while (0)
#define LRU_TILE_WRITE(CH, SLOT) do { LAS unsigned char* _T = wl + ((CH) & 1) * 2816; \
        _Pragma("unroll") for (int i = 0; i < 3; ++i) { const int pc = lane + 64 * i; if (pc < 152) *(LAS u32x4*)(_T + (pc >> 3) * 144 + (pc & 7) * 16) = ring[SLOT][i]; } } while (0)
#define LRU_MFMA(CH, RO, IO) do { const LAS unsigned char* _T = wl + ((CH) & 1) * 2816; const int _tau0 = (CH) * 16; const int _PLO = d ? (L - 16 - _tau0) : _tau0; \
        const int _posc = d ? (L - 1 - (_tau0 + col)) : (_tau0 + col); RO = (f32x4){0.f, 0.f, 0.f, 0.f}; IO = (f32x4){0.f, 0.f, 0.f, 0.f}; \
        _Pragma("unroll") for (int j = 0; j < 4; ++j) _Pragma("unroll") for (int kk = 0; kk < 2; ++kk) { const bf16x8 af = *(const LAS bf16x8*)(_T + (_posc - _PLO + j) * 144 + kk * 64 + q * 16); \
            RO = __builtin_amdgcn_mfma_f32_16x16x32_bf16(af, WfR[j][kk], RO, 0, 0, 0); IO = __builtin_amdgcn_mfma_f32_16x16x32_bf16(af, WfI[j][kk], IO, 0, 0, 0); } } while (0)
    u32x4 ring[3][3];
    LRU_LOAD(ring[0], 0); LRU_LOAD(ring[1], 1); LRU_LOAD(ring[2], 2);
    f32x4 Rg, Ig;
    LRU_TILE_WRITE(0, 0); LRU_LOAD(ring[0], 3);
    asm volatile("s_waitcnt lgkmcnt(0)" ::: "memory");
    LRU_MFMA(0, Rg, Ig);
    for (int ch3 = 0; ch3 < nch; ch3 += 3) {
#pragma unroll
      for (int k3 = 0; k3 < 3; ++k3) {
        const int ch = ch3 + k3;
        const int tau0 = ch * 16;
        const int PLO = d ? (L - 16 - tau0) : tau0;
        const LAS unsigned char* T = wl + (ch & 1) * 2816;
        const bool more = (ch + 1 < nch);
        if (more) { LRU_TILE_WRITE(ch + 1, (k3 + 1) % 3); LRU_LOAD(ring[(k3 + 1) % 3], ch + 4); }
        const int ploq = d ? (L - 4 - tau0 - 4 * q) : (tau0 + 4 * q);
        float xw[7];
#pragma unroll
        for (int i = 0; i < 7; ++i) xw[i] = bf2f(*(const LAS bf16_t*)(T + (ploq - PLO + i) * 144 + no * 2));
        asm volatile("s_waitcnt lgkmcnt(0)" ::: "memory");
        f32x4 Rn = {0.f, 0.f, 0.f, 0.f}, In = {0.f, 0.f, 0.f, 0.f};
        if (more) LRU_MFMA(ch + 1, Rn, In);
        float xcp[4];
#pragma unroll
        for (int i = 0; i < 4; ++i) xcp[i] = cb0 + cw0 * xw[i] + cw1 * xw[i + 1] + cw2 * xw[i + 2] + cw3 * xw[i + 3];
        float av[4], bv[4];
#pragma unroll
        for (int r = 0; r < 4; ++r) {
            const float xcv = d ? xcp[3 - r] : xcp[r];
            const float e1 = __expf(-(Rg[r] + br)), e2 = __expf(-(Ig[r] + bi));
            const float inv = __builtin_amdgcn_rcpf((1.0f + e1) * (1.0f + e2));
            const float rg = (1.0f + e2) * inv, ig = (1.0f + e1) * inv;
            const float a = __expf(-8.0f * rg * sp);
            av[r] = a; bv[r] = __builtin_amdgcn_sqrtf(fmaxf(1.0f - a * a, 0.f)) * ig * xcv;
        }
        float A = av[0], B = bv[0];
#pragma unroll
        for (int r = 1; r < 4; ++r) { B = av[r] * B + bv[r]; A = A * av[r]; }
        { const float A1 = __shfl_up(A, 16), B1 = __shfl_up(B, 16); if (q >= 1) { B = A * B1 + B; A = A * A1; } }
        { const float A2 = __shfl_up(A, 32), B2 = __shfl_up(B, 32); if (q >= 2) { B = A * B2 + B; A = A * A2; } }
        const float hend = A * carry + B;
        const float hprev = __shfl_up(hend, 16);
        float h = (q == 0) ? carry : hprev;
        carry = __shfl(hend, 48 + col);
#pragma unroll
        for (int r = 0; r < 4; ++r) { h = av[r] * h + bv[r]; const int tau = tau0 + 4 * q + r; const int pos = d ? (L - 1 - tau) : tau; outb[((size_t)(32 + hb * 4 + nt) * MP + rb + pos) * 16 + col] = f2bf(h); }
        Rg = Rn; Ig = In;
        asm volatile("s_waitcnt lgkmcnt(0)" ::: "memory");
      }
    }
#undef LRU_TILE_WRITE
#undef LRU_MFMA
#undef LRU_LOAD
}

__device__ __forceinline__ void scan_unit(const Params& p, LAS unsigned char* wl, int lane, int j, const bf16_t* Z, bf16_t* SF, bf16_t* SB) {
    if (j < 256) { const int s = 16 + (j >> 6), d = (j >> 5) & 1, g = j & 31; s5_unit(p, wl, s, d, g, lane, Z, d ? SB : SF); }
    else if (j < 512) { const int k = j - 256; const int s = 16 + (k >> 6), d = (k >> 5) & 1, hb = (k >> 2) & 7, nt = k & 3; lru_unit(p, wl, s, d, hb, nt, lane, Z, d ? SB : SF); }
    else if (j < 1536) { const int k = j - 512; const int s = k >> 6, d = (k >> 5) & 1, g = k & 31; s5_unit(p, wl, s, d, g, lane, Z, d ? SB : SF); }
    else { const int k = j - 1536; const int s = k >> 6, d = (k >> 5) & 1, hb = (k >> 2) & 7, nt = k & 3; lru_unit(p, wl, s, d, hb, nt, lane, Z, d ? SB : SF); }
}
__device__ __forceinline__ void phase_scan(const Params& p, LAS unsigned char* lds) {
    int tid = threadIdx.x; asm volatile("" : "+v"(tid)); const int lane = tid & 63, wid = __builtin_amdgcn_readfirstlane(tid >> 6);
    LAS unsigned char* wl = lds + wid * WLDS;
    const bf16_t* Z = (const bf16_t*)(p.ws + OFF_DYN);
    bf16_t* SF = (bf16_t*)(p.ws + OFF_DYN + SZ_Z); bf16_t* SB = (bf16_t*)p.out;
    const int nslots = gridDim.x * 8, slot = wid * gridDim.x + blockIdx.x;
    const bool lpt = (nslots == 2048);
    int u0 = 0, u1 = 0, nu = 0;
    if (lpt) {
        if (slot < 512) { u0 = (slot & 1) * 256 + (slot >> 1); nu = 1; }
        else { const int k = slot - 512; u0 = 512 + (k & 1) * 1024 + (k >> 1); nu = 1;
            if (k < 512) { const int u = 1536 + k; u1 = 512 + (u & 1) * 1024 + (u >> 1); nu = 2; } }
    }
    for (int it = 0;; ++it) {
        int j;
        if (lpt) { if (it >= nu) break; j = it ? u1 : u0; } else { j = slot + it * nslots; if (j >= 2560) break; }
        scan_unit(p, wl, lane, j, Z, SF, SB);
    }
    if (lpt) { if (slot >= 1024) cvt_rest(p, (long)(slot - 1024) * 64 + lane, 1024L * 64); }
    else cvt_rest(p, (long)slot * 64 + lane, (long)nslots * 64);
}

__device__ __forceinline__ void phase_combine(const Params& p) {
    const bf16_t* Z = (const bf16_t*)(p.ws + OFF_DYN);
    bf16_t* SF = (bf16_t*)(p.ws + OFF_DYN + SZ_Z); bf16_t* SB = (bf16_t*)p.out;
    const float* dsk = p.in[14];
    const long total = 64L * R * 2, nth = (long)gridDim.x * blockDim.x;
    int tid = threadIdx.x; asm volatile("" : "+v"(tid));
    for (long t0 = (long)blockIdx.x * blockDim.x + tid; t0 < total; t0 += 2 * nth) {
        u32x4 f[2], b[2], u[2]; size_t off[2]; int c8v[2]; bool ok[2];
#pragma unroll
        for (int j = 0; j < 2; ++j) {
            const long t = t0 + j * nth; ok[j] = t < total; off[j] = 0; c8v[j] = 0;
            if (ok[j]) {
                const int blk = (int)(t / (2L * R)); const int rem = (int)(t - (long)blk * 2 * R); const int r = rem >> 1, c8 = blk * 16 + (rem & 1) * 8;
                off[j] = ((size_t)blk * MP + r) * 16 + (rem & 1) * 8; c8v[j] = c8;
                f[j] = *(const u32x4*)(SF + off[j]); b[j] = *(const u32x4*)(SB + off[j]);
                u[j] = *(const u32x4*)(Z + (size_t)r * 1536 + (c8 < 512 ? c8 : 512 + c8));
            }
        }
#pragma unroll
        for (int j = 0; j < 2; ++j) {
            if (!ok[j]) continue;
            const int c8 = c8v[j];
            const float s0 = bflo(f[j].x) + bflo(b[j].x), s1 = bfhi(f[j].x) + bfhi(b[j].x), s2 = bflo(f[j].y) + bflo(b[j].y), s3 = bfhi(f[j].y) + bfhi(b[j].y);
            const float s4 = bflo(f[j].z) + bflo(b[j].z), s5 = bfhi(f[j].z) + bfhi(b[j].z), s6 = bflo(f[j].w) + bflo(b[j].w), s7 = bfhi(f[j].w) + bfhi(b[j].w);
            float o[8];
            if (c8 < 512) {
                const f32x4 d0 = *(const f32x4*)(dsk + c8), d1 = *(const f32x4*)(dsk + c8 + 4);
                o[0] = gelu_t(s0 + d0[0] * bflo(u[j].x)); o[1] = gelu_t(s1 + d0[1] * bfhi(u[j].x)); o[2] = gelu_t(s2 + d0[2] * bflo(u[j].y)); o[3] = gelu_t(s3 + d0[3] * bfhi(u[j].y));
                o[4] = gelu_t(s4 + d1[0] * bflo(u[j].z)); o[5] = gelu_t(s5 + d1[1] * bfhi(u[j].z)); o[6] = gelu_t(s6 + d1[2] * bflo(u[j].w)); o[7] = gelu_t(s7 + d1[3] * bfhi(u[j].w));
                u32x4 w; w.x = pack2(o[0], o[1]); w.y = pack2(o[2], o[3]); w.z = pack2(o[4], o[5]); w.w = pack2(o[6], o[7]);
                *(u32x4*)(SF + off[j]) = w;
            } else {
                o[0] = s0 * gelu_t(bflo(u[j].x)); o[1] = s1 * gelu_t(bfhi(u[j].x)); o[2] = s2 * gelu_t(bflo(u[j].y)); o[3] = s3 * gelu_t(bfhi(u[j].y));
                o[4] = s4 * gelu_t(bflo(u[j].z)); o[5] = s5 * gelu_t(bfhi(u[j].z)); o[6] = s6 * gelu_t(bflo(u[j].w)); o[7] = s7 * gelu_t(bfhi(u[j].w));
                u32x4 w; w.x = pack2(o[0], o[1]); w.y = pack2(o[2], o[3]); w.z = pack2(o[4], o[5]); w.w = pack2(o[6], o[7]);
                *(u32x4*)(SB + off[j]) = w;
            }
        }
    }
}

__device__ __forceinline__ void phase_attn(const Params& p) {
    int tid = threadIdx.x; asm volatile("" : "+v"(tid)); const int lane = tid & 63, wid = tid >> 6;
    const bf16_t* QK = (const bf16_t*)(p.ws + OFF_DYN);
    const bf16_t* KT = (const bf16_t*)(p.ws + OFF_DYN + SZ_ROWS);
    const bf16_t* VT = (const bf16_t*)(p.ws + OFF_DYN + SZ_ROWS + SZ_VT);
    bf16_t* O = (bf16_t*)(p.ws + OFF_DYN + SZ_ROWS + 2 * SZ_VT);
    const float* sink = p.in[27];
    const int qi = lane & 31, h = lane >> 5;
    const int nitems = (16 * 65 + 4 * 257) * 16, nw = gridDim.x * 8;
    const float LOG2E = 1.4426950408889634f;
#define ATT_ITEM(IT, hq_, hk_, rb_, L_, q0_, lo_, hi_) do { hq_ = (IT) & 15; const int _tile = (IT) >> 4; hk_ = hq_ >> 2; int _tq; \
        if (_tile < 16 * 65) { const int _s = _tile / 65; _tq = _tile - _s * 65; rb_ = _s * LP; L_ = LP; } else { const int _t2 = _tile - 16 * 65; const int _s = _t2 / 257; _tq = _t2 - _s * 257; rb_ = RP + _s * LS; L_ = LS; } \
        q0_ = _tq * 32; lo_ = (q0_ >= 128) ? 0 : 4 - (q0_ >> 5); hi_ = (L_ - q0_ + 127) >> 5; hi_ = hi_ > 8 ? 8 : hi_; } while (0)
#define ATT_QLOAD(Qd, rb_, L_, q0_, hq_) do { const int _qp = (q0_) + qi; const int _qr = (rb_) + (_qp < (L_) ? _qp : (L_) - 1); \
        _Pragma("unroll") for (int s = 0; s < 4; ++s) Qd[s] = *(const bf16x8*)(QK + (size_t)_qr * 1024 + (hq_) * 64 + 16 * s + 8 * h); } while (0)
#define ATT_LOADX(kf, vr, KB, q0_, L_, rb_, kbase_, vbase_) do { const int _k0 = (q0_) - 128 + 32 * (KB); int _kp = _k0 + qi; _kp = _kp < 0 ? 0 : (_kp > (L_) - 1 ? (L_) - 1 : _kp); \
        const int _kfl = (rb_) + _kp; const bf16_t* _kr = (kbase_) + (size_t)(_kfl >> 4) * 1024 + (_kfl & 15) * 16; \
        _Pragma("unroll") for (int s = 0; s < 4; ++s) kf[s] = *(const u32x4*)(_kr + 256 * s); \
        _Pragma("unroll") for (int sp = 0; sp < 2; ++sp) _Pragma("unroll") for (int hf = 0; hf < 2; ++hf) { int gk = _k0 + 16 * sp + 8 * hf + 4 * h; if (gk < 0 || gk >= (L_)) gk = 0; \
            const int _fl = (rb_) + gk; const bf16_t* _vp = (vbase_) + (size_t)(_fl >> 4) * 1024 + (_fl & 15); \
            _Pragma("unroll") for (int t = 0; t < 2; ++t) vr[sp][t][hf] = *(const u32x2*)(_vp + 512 * t); } } while (0)
#define ATT_BLOCK(kf, vr, KB, SETIDX) do { const int kb = (KB); const int k0 = q0 - 128 + 32 * kb; \
            f32x16 S; _Pragma("unroll") for (int r = 0; r < 16; ++r) S[r] = 0.f; \
            _Pragma("unroll") for (int s = 0; s < 4; ++s) S = __builtin_amdgcn_mfma_f32_32x32x16_bf16(__builtin_bit_cast(bf16x8, kf[s]), Qf[s], S, 0, 0, 0); \
            u32x4 v0[2], v1[2]; \
            _Pragma("unroll") for (int sp = 0; sp < 2; ++sp) { v0[sp].x = vr[sp][0][0].x; v0[sp].y = vr[sp][0][0].y; v0[sp].z = vr[sp][0][1].x; v0[sp].w = vr[sp][0][1].y; \
                v1[sp].x = vr[sp][1][0].x; v1[sp].y = vr[sp][1][0].y; v1[sp].z = vr[sp][1][1].x; v1[sp].w = vr[sp][1][1].y; } \
            if (kb + 2 <= kb_hi) ATT_LOADX(kf, vr, kb + 2, q0, L, rb, kbase, vbase); \
            else if (has_next) { ATT_LOADX(kf, vr, kbn_lo + (SETIDX), q0n, Ln, rbn, kbasen, vbasen); if ((SETIDX) == 0) ATT_QLOAD(Qn, rbn, Ln, q0n, hqn); } \
            const bool full = (kb >= 1) && (kb <= 7) && (k0 >= 0) && (k0 + 31 < L); \
            const int dq = qpos - k0 - 4 * h; const float fdq = (float)dq; \
            float sc[16]; float bm = -1e30f; \
            if (full) { _Pragma("unroll") for (int r = 0; r < 16; ++r) { const float t = fdq - (float)((r & 3) + 8 * (r >> 2)); sc[r] = S[r] - slope * fabsf(t); bm = fmaxf(bm, sc[r]); } } \
            else { _Pragma("unroll") for (int r = 0; r < 16; ++r) { const int kk = (r & 3) + 8 * (r >> 2); const int kp = k0 + kk + 4 * h; int dist = dq - kk; dist = dist < 0 ? -dist : dist; \
                    const bool valid = (dist <= 128) && (kp >= 0) && (kp < L); sc[r] = valid ? (S[r] - slope * (float)dist) : -1e30f; bm = fmaxf(bm, sc[r]); } } \
            bm = fmaxf(bm, __shfl_xor(bm, 32)); \
            const float mn = fmaxf(m, bm), alpha = __builtin_amdgcn_exp2f(m - mn); m = mn; \
            float ps = 0.f; float pv[16]; \
            _Pragma("unroll") for (int r = 0; r < 16; ++r) { pv[r] = __builtin_amdgcn_exp2f(sc[r] - mn); ps += pv[r]; } \
            l = l * alpha + ps; \
            if (__builtin_amdgcn_ballot_w64(alpha < 1.0f) != 0ull) { _Pragma("unroll") for (int r = 0; r < 16; ++r) { O0[r] *= alpha; O1[r] *= alpha; } } \
            _Pragma("unroll") for (int sp = 0; sp < 2; ++sp) { \
                u32x4 pw; pw.x = pack2(pv[8 * sp + 0], pv[8 * sp + 1]); pw.y = pack2(pv[8 * sp + 2], pv[8 * sp + 3]); pw.z = pack2(pv[8 * sp + 4], pv[8 * sp + 5]); pw.w = pack2(pv[8 * sp + 6], pv[8 * sp + 7]); \
                const bf16x8 Pf = __builtin_bit_cast(bf16x8, pw); \
                O0 = __builtin_amdgcn_mfma_f32_32x32x16_bf16(__builtin_bit_cast(bf16x8, v0[sp]), Pf, O0, 0, 0, 0); \
                O1 = __builtin_amdgcn_mfma_f32_32x32x16_bf16(__builtin_bit_cast(bf16x8, v1[sp]), Pf, O1, 0, 0, 0); } } while (0)
    int it = blockIdx.x * 8 + wid;
    if (it < nitems) {
        int hq, hk, rb, L, q0, kb_lo, kb_hi;
        ATT_ITEM(it, hq, hk, rb, L, q0, kb_lo, kb_hi);
        bf16x8 Qf[4];
        ATT_QLOAD(Qf, rb, L, q0, hq);
        u32x4 kfA[4], kfB[4]; u32x2 vrA[2][2][2], vrB[2][2][2];
        { const bf16_t* kbase = KT + (size_t)hk * (MP / 16) * 1024 + 8 * h; const bf16_t* vbase = VT + ((size_t)hk * (MP / 16) * 64 + qi) * 16;
          ATT_LOADX(kfA, vrA, kb_lo, q0, L, rb, kbase, vbase); ATT_LOADX(kfB, vrB, kb_lo + 1, q0, L, rb, kbase, vbase); }
        for (;;) {
            const int itn = it + nw; const bool has_next = itn < nitems;
            int hqn = 0, hkn = 0, rbn = 0, Ln = LP, q0n = 0, kbn_lo = 4, kbn_hi = 8;
            if (has_next) ATT_ITEM(itn, hqn, hkn, rbn, Ln, q0n, kbn_lo, kbn_hi);
            const bf16_t* kbase = KT + (size_t)hk * (MP / 16) * 1024 + 8 * h; const bf16_t* vbase = VT + ((size_t)hk * (MP / 16) * 64 + qi) * 16;
            const bf16_t* kbasen = KT + (size_t)hkn * (MP / 16) * 1024 + 8 * h; const bf16_t* vbasen = VT + ((size_t)hkn * (MP / 16) * 64 + qi) * 16;
            bf16x8 Qn[4];
#pragma unroll
            for (int s = 0; s < 4; ++s) Qn[s] = Qf[s];
            const int qpos = q0 + qi;
            const float slope = exp2f(-0.5f * (float)(hq + 1)) * LOG2E;
            float m = sink[hq] * LOG2E, l = (h == 0) ? 1.0f : 0.0f;
            f32x16 O0, O1;
#pragma unroll
            for (int r = 0; r < 16; ++r) { O0[r] = 0.f; O1[r] = 0.f; }
            for (int kb2 = kb_lo; kb2 <= kb_hi; kb2 += 2) {
                ATT_BLOCK(kfA, vrA, kb2, 0);
                if (kb2 + 1 <= kb_hi) ATT_BLOCK(kfB, vrB, kb2 + 1, 1);
            }
            l += __shfl_xor(l, 32);
            const float inv = 1.0f / l;
            if (qpos < L) {
                bf16_t* orow = O + (size_t)(rb + qpos) * 1024 + hq * 64 + 4 * h;
#pragma unroll
                for (int r4 = 0; r4 < 4; ++r4) {
                    u32x2 w0; w0.x = pack2(O0[4 * r4] * inv, O0[4 * r4 + 1] * inv); w0.y = pack2(O0[4 * r4 + 2] * inv, O0[4 * r4 + 3] * inv); *(u32x2*)(orow + 8 * r4) = w0;
                    u32x2 w1; w1.x = pack2(O1[4 * r4] * inv, O1[4 * r4 + 1] * inv); w1.y = pack2(O1[4 * r4 + 2] * inv, O1[4 * r4 + 3] * inv); *(u32x2*)(orow + 32 + 8 * r4) = w1;
                }
            }
            if (!has_next) break;
            it = itn; hq = hqn; hk = hkn; rb = rbn; L = Ln; q0 = q0n; kb_lo = kbn_lo; kb_hi = kbn_hi;
#pragma unroll
            for (int s = 0; s < 4; ++s) Qf[s] = Qn[s];
        }
    }
#undef ATT_BLOCK
#undef ATT_LOADX
#undef ATT_QLOAD
#undef ATT_ITEM
}

__device__ __forceinline__ void phase_final(const Params& p) {
    int tid = threadIdx.x; asm volatile("" : "+v"(tid)); const int lane = tid & 63, wid = tid >> 6;
    const bf16_t* H = (const bf16_t*)(p.ws + OFF_HPAD) + 8 * 1024; const float* rss = (const float*)(p.ws + OFF_RSS);
    const float* g = p.in[5];
    const int nw = gridDim.x * 8;
    for (int r0 = blockIdx.x * 8 + wid; r0 < R; r0 += 2 * nw) {
        u32x2 hw[2][4]; float rs[2]; bool ok[2]; size_t orow[2];
#pragma unroll
        for (int j = 0; j < 2; ++j) {
            const int r = r0 + j * nw; ok[j] = false; rs[j] = 0.f; orow[j] = 0;
            if (r < R) { int pos, len; row_pos(r, pos, len);
                if (pos >= 16) { ok[j] = true;
                    if (r < RP) { const int s = r / LP; orow[j] = (size_t)s * 2048 + pos - 16; } else { const int s = (r - RP) / LS; orow[j] = (size_t)16 * 2048 + (size_t)s * 8192 + pos - 16; }
                    rs[j] = rowscale(rss, r);
#pragma unroll
                    for (int i = 0; i < 4; ++i) hw[j][i] = *(const u32x2*)(H + (size_t)r * 1024 + i * 256 + lane * 4); } }
        }
#pragma unroll
        for (int j = 0; j < 2; ++j) {
            if (!ok[j]) continue;
            float* op = p.out + orow[j] * 1024;
#pragma unroll
            for (int i = 0; i < 4; ++i) { const int c = i * 256 + lane * 4; const f32x4 gv = *(const f32x4*)(g + c); const u32x2 w = hw[j][i];
                f32x4 o; o[0] = bflo(w.x) * rs[j] * gv[0]; o[1] = bfhi(w.x) * rs[j] * gv[1]; o[2] = bflo(w.y) * rs[j] * gv[2]; o[3] = bfhi(w.y) * rs[j] * gv[3]; *(f32x4*)(op + c) = o; }
        }
    }
}

#define XB_TMO      128
#define XB_XCNT(j)  (256  + 64 * (j))
#define XB_XSUB(j)  (1280 + 64 * (j))
#define XB_XGEN(j)  (2304 + 64 * (j))
#define XB_TOP      3328
#define XB_TOPGEN   3392
#define XCD_BAR_WORDS 3456
#define XB_SPIN_CAP (1u << 22)
__device__ __forceinline__ unsigned xb_ld(unsigned* p)              { return __hip_atomic_load(p, __ATOMIC_RELAXED, __HIP_MEMORY_SCOPE_AGENT); }
__device__ __forceinline__ unsigned xb_add(unsigned* p, unsigned v) { return __hip_atomic_fetch_add(p, v, __ATOMIC_RELAXED, __HIP_MEMORY_SCOPE_AGENT); }
__device__ __forceinline__ unsigned xb_xcc_id() { return (unsigned)__builtin_amdgcn_s_getreg((3 << 11) | 20) & 0xFu; }
#define XB_SPIN(cond, bar) do { unsigned _sp = 0; while (cond) { __builtin_amdgcn_s_sleep(1); \
    if ((++_sp & 255u) == 0u) { if (xb_ld(&(bar)[XB_TMO])) break; if (_sp > XB_SPIN_CAP) { atomicAdd(&(bar)[XB_TMO], 1u); break; } } } } while (0)
struct XcdBarrier { unsigned* bar; unsigned x; volatile LAS unsigned* st; };
__device__ __forceinline__ XcdBarrier xcd_barrier_post(unsigned* bar, volatile LAS unsigned* st) {
    XcdBarrier b; b.bar = bar; b.x = xb_xcc_id(); b.st = st;
    if (threadIdx.x == 0) (void)xb_add(&bar[XB_XCNT(b.x)], 1u);
    return b;
}
__device__ __forceinline__ void xcd_barrier_complete(unsigned* bar, unsigned x, unsigned& nloc, unsigned& nx) {
    const unsigned G = gridDim.x * gridDim.y * gridDim.z;
    unsigned sum, cnt, mine, sp = 0u;
    for (;;) {
        sum = 0u; cnt = 0u; mine = 0u;
#pragma unroll
        for (unsigned j = 0; j < 16; ++j) { const unsigned c = xb_ld(&bar[XB_XCNT(j)]); sum += c; cnt += (c > 0u) ? 1u : 0u; mine = (j == x) ? c : mine; }
        if (sum == G) break;
        __builtin_amdgcn_s_sleep(1);
        if ((++sp & 255u) == 0u) { if (xb_ld(&bar[XB_TMO])) break; if (sp > XB_SPIN_CAP) { atomicAdd(&bar[XB_TMO], 1u); break; } }
    }
    nloc = mine > 0u ? mine : 1u; nx = cnt > 0u ? cnt : 1u;
}
__device__ __forceinline__ void xcd_barrier(const XcdBarrier& b) {
    asm volatile("s_waitcnt vmcnt(0)" ::: "memory");
    __syncthreads();
    if (threadIdx.x == 0) {
        unsigned* bar = b.bar;
        __builtin_amdgcn_s_waitcnt(0);
        unsigned nloc = b.st[0], nx = b.st[1];
        if (nloc == 0u) { xcd_barrier_complete(bar, b.x, nloc, nx); b.st[0] = nloc; b.st[1] = nx; }
        const unsigned old = xb_add(&bar[XB_XSUB(b.x)], 1u);
        const unsigned gen = old / nloc;
        if (old + 1u == (gen + 1u) * nloc) {
            __builtin_amdgcn_fence(__ATOMIC_RELEASE, "agent");
            asm volatile("s_waitcnt vmcnt(0)" ::: "memory");
            const unsigned og = xb_add(&bar[XB_TOP], 1u);
            const unsigned tg = og / nx;
            if (og + 1u == (tg + 1u) * nx) xb_add(&bar[XB_TOPGEN], 1u);
            else XB_SPIN(xb_ld(&bar[XB_TOPGEN]) == tg, bar);
            __builtin_amdgcn_fence(__ATOMIC_ACQUIRE, "agent");
            xb_add(&bar[XB_XGEN(b.x)], 1u);
            asm volatile("s_waitcnt vmcnt(0)" ::: "memory");
        } else {
            XB_SPIN(xb_ld(&bar[XB_XGEN(b.x)]) == gen, bar);
            __builtin_amdgcn_fence(__ATOMIC_ACQUIRE, "agent");
            asm volatile("s_waitcnt vmcnt(0)" ::: "memory");
        }
    }
    __syncthreads();
}

constexpr int NPHASE = 14;
#ifndef REP_PH
#define REP_PH -1
#define REP_N 1
#endif
__global__ void __launch_bounds__(512, 2) mega(Params p) {
    extern __shared__ __attribute__((aligned(16))) unsigned char smem[];
    LAS unsigned char* lds = (LAS unsigned char*)smem;
    if (threadIdx.x < 4) ((LAS unsigned*)(lds + LDS_BARW))[threadIdx.x] = 0u;
    __syncthreads();
    XcdBarrier xbar = xcd_barrier_post((unsigned*)(p.ws + OFF_BAR), (volatile LAS unsigned*)(lds + LDS_BARW));
    unsigned char* ws = p.ws;
    bf16_t* H = (bf16_t*)(ws + OFF_HPAD) + 8 * 1024; float* rss = (float*)(ws + OFF_RSS);
    const char* DYN = (const char*)(ws + OFF_DYN);
    const int G = gridDim.x, bx = blockIdx.x;
    for (int phx = p.ph_lo, rep = 0; phx < p.ph_hi; ) {
        const int ph = phx;
        if (ph == 0) phase_prep(p);
        else if (ph == 1 || ph == 8) {
            const bool at = (ph == 8);
            pg8::GemmDesc g{(const char*)H, (const char*)H, 1 << 30, 1024, (const char*)(ws + (at ? OFF_WQKV : OFF_WIN)), 1024, 0}; pg8::StaticOrder S; S.init(NT256, 6, G, bx);
            EpiScale E{(bf16_t*)(ws + OFF_DYN), at ? 1024 : 1536, rss, (bf16_t*)(ws + OFF_DYN + SZ_ROWS + SZ_VT), at ? 5 : (1 << 30), (bf16_t*)(ws + OFF_DYN + SZ_ROWS)}; pg8::gemm_phase<false>(lds, g, S, E);
        } else if (ph == 2) phase_scan(p, lds);
        else if (ph == 3) phase_combine(p);
        else if (ph == 4) {
            pg8::GemmDesc g{DYN + SZ_Z, DYN + SZ_Z, 1 << 30, 1024, (const char*)(ws + OFF_WGLU), 512, 1}; pg8::StaticOrder S; S.init(NT256, 2, G, bx);
            EpiGlu E{(const bf16_t*)(DYN + SZ_Z), (bf16_t*)p.out, p.in[16]}; pg8::gemm_phase<false>(lds, g, S, E);
        } else if (ph == 5 || ph == 7 || ph == 10 || ph == 12) {
            const char* A1; const char* A2; int split = 1 << 30, lda = 1024; size_t woff;
            if (ph == 5) { A1 = (const char*)p.out; A2 = A1; woff = OFF_WOUT; }
            else if (ph == 10) { A1 = DYN + SZ_ROWS + 2 * SZ_VT; A2 = A1; woff = OFF_WO; }
            else { A1 = DYN; A2 = (const char*)p.out; split = RSPLIT / 256; lda = DFF; woff = (ph == 7) ? OFF_WDN0 : OFF_WDN1; }
            pg8::GemmDesc g{A1, A2, split, lda, (const char*)(ws + woff), lda, ph == 5 ? 1 : 0}; pg8::StaticOrder S; S.init(ph == 12 ? 256 : NT256, 4, G, bx);
            EpiRes E{H, rss, ph == 12 ? 1 : 0}; pg8::gemm_phase<false>(lds, g, S, E);
        } else if (ph == 6 || ph == 11) {
            const int l = ph == 6 ? 0 : 1;
            pg8::GemmDesc g{(const char*)H, (const char*)H, 1 << 30, 1024, (const char*)(ws + (l ? OFF_WUP1 : OFF_WUP0)), 1024, 0}; pg8::StaticOrder S; S.init(NTUP, 22, G, bx);
            EpiUp E{(bf16_t*)(ws + OFF_DYN), (bf16_t*)p.out, rss, p.in[29] + (size_t)l * 3 * 5632, p.in[30] + (size_t)l * 5632, l}; pg8::gemm_phase<true>(lds, g, S, E);
        } else if (ph == 9) phase_attn(p);
        else if (ph == 13) phase_final(p);
        ++rep; if (!(ph == p.rep_ph && rep < p.rep_n)) { ++phx; rep = 0; }
        if (phx < p.ph_hi) { if (p.ph_lo < 0) cg::this_grid().sync(); else xcd_barrier(xbar); }
    }
}

extern "C" void kernel_launch(void* const* d_in, const int* in_sizes, int n_in, void* d_out, int out_size, void* d_ws, size_t ws_size, hipStream_t stream) {
    static int grid = 0;
    if (grid == 0) {
        if (n_in != 32 || ws_size < WS_NEED) { fprintf(stderr, "kernel_launch: bad args n_in %d ws %zu need %zu\n", n_in, ws_size, (size_t)WS_NEED); grid = -1; return; }
        int dev = 0, cus = 0, per_cu = 0;
        hipGetDevice(&dev); hipDeviceGetAttribute(&cus, hipDeviceAttributeMultiprocessorCount, dev);
        hipFuncSetAttribute((const void*)mega, hipFuncAttributeMaxDynamicSharedMemorySize, LDS_BYTES);
        hipOccupancyMaxActiveBlocksPerMultiprocessor(&per_cu, (const void*)mega, 512, LDS_BYTES);
        (void)hipGetLastError();
        if (per_cu < 1) per_cu = 1;
        grid = cus * 1;
    }
    if (grid < 0) return;
    (void)hipMemsetAsync((char*)d_ws + OFF_BAR, 0, SZ_BAR, stream);
    Params p{};
    for (int i = 0; i < 32; ++i) p.in[i] = (const float*)d_in[i];
    p.out = (float*)d_out; p.ws = (unsigned char*)d_ws;
#if defined(MULTI_LAUNCH)
    for (int ph = 0; ph < NPHASE; ++ph) { p.ph_lo = ph; p.ph_hi = ph + 1; hipLaunchKernelGGL(mega, dim3(grid), dim3(512), LDS_BYTES, stream, p); }
#else
    p.ph_lo = 0; p.ph_hi = NPHASE; p.rep_ph = REP_PH; p.rep_n = REP_N;
    void* args[] = {&p};
    hipError_t e = hipLaunchCooperativeKernel((const void*)mega, dim3(grid), dim3(512), args, LDS_BYTES, stream);
    if (e != hipSuccess) fprintf(stderr, "cooperative launch failed: %s (grid %d)\n", hipGetErrorString(e), grid);
#endif
}
```

```cpp
#include <hip/hip_runtime.h>
#include <hip/hip_cooperative_groups.h>
#include <cstdio>
namespace cg = cooperative_groups;

#define LAS __attribute__((address_space(3)))
typedef unsigned short bf16_t;
typedef short bf16x8 __attribute__((ext_vector_type(8)));
typedef short bf16x4 __attribute__((ext_vector_type(4)));
typedef float f32x4 __attribute__((ext_vector_type(4)));
typedef float f32x16 __attribute__((ext_vector_type(16)));
typedef unsigned u32x2 __attribute__((ext_vector_type(2)));
typedef unsigned u32x4 __attribute__((ext_vector_type(4)));

constexpr int DM = 1024;
constexpr int LP = 2064, LS = 8208;
constexpr int RP = 16 * LP;
constexpr int R = RP + 4 * LS;
constexpr int MP = 66048;
constexpr int NT256 = 258;
constexpr int NTUP = 266;
constexpr int DFF = 2816;
constexpr int RSPLIT = 59392;
constexpr float EPS = 1e-6f;

constexpr size_t SZ_WIN = 1536ull * 1024 * 2, SZ_WGLU = 512ull * 512 * 2, SZ_WSQ = 1024ull * 1024 * 2, SZ_WUP = 5632ull * 1024 * 2, SZ_WDN = 1024ull * 2816 * 2;
constexpr size_t OFF_BAR = 0, SZ_BAR = 16384;
constexpr size_t OFF_WIN = OFF_BAR + SZ_BAR;
constexpr size_t OFF_WGLU = OFF_WIN + SZ_WIN;
constexpr size_t OFF_WOUT = OFF_WGLU + SZ_WGLU;
constexpr size_t OFF_WQKV = OFF_WOUT + SZ_WSQ;
constexpr size_t OFF_WO = OFF_WQKV + SZ_WIN;
constexpr size_t OFF_WUP0 = OFF_WO + SZ_WSQ;
constexpr size_t OFF_WUP1 = OFF_WUP0 + SZ_WUP;
constexpr size_t OFF_WDN0 = OFF_WUP1 + SZ_WUP;
constexpr size_t OFF_WDN1 = OFF_WDN0 + SZ_WDN;
constexpr size_t OFF_RSS = OFF_WDN1 + SZ_WDN;
constexpr size_t SZ_RSS = (size_t)MP * 16 * 4;
constexpr size_t OFF_HPAD = OFF_RSS + SZ_RSS;
constexpr size_t SZ_H = (size_t)(MP + 8) * 1024 * 2;
constexpr size_t OFF_DYN = OFF_HPAD + SZ_H;
constexpr size_t SZ_Z = (size_t)MP * 1536 * 2;
constexpr size_t SZ_ROWS = (size_t)MP * 1024 * 2;
constexpr size_t SZ_QK = (size_t)MP * 1280 * 2;
constexpr size_t SZ_VT = 256ull * MP * 2;
constexpr size_t DYN_SIZE = 2 * SZ_ROWS + 2 * SZ_VT;
constexpr size_t WS_NEED = OFF_DYN + DYN_SIZE;
constexpr int LDS_STAGE = 131072, AUX_OFF = LDS_STAGE + 256, AUXSZ = 6144, LDS_BARW = 8 * 18944, LDS_BYTES = LDS_BARW + 256;
static_assert((size_t)RSPLIT * DFF * 2 <= DYN_SIZE, "act split");
static_assert(SZ_Z + SZ_ROWS <= DYN_SIZE, "ab layer");

struct Params {
    const float* in[32];
    float* out;
    unsigned char* ws;
    int ph_lo, ph_hi;
    int rep_ph, rep_n;
};

typedef __bf16 bf16v2 __attribute__((ext_vector_type(2)));
typedef float f32v2 __attribute__((ext_vector_type(2)));
__device__ __forceinline__ unsigned pack2(float lo, float hi) { const f32v2 f = {lo, hi}; const bf16v2 v = __builtin_convertvector(f, bf16v2); return __builtin_bit_cast(unsigned, v); }
__device__ __forceinline__ bf16_t f2bf(float f) { return (bf16_t)(pack2(f, 0.f) & 0xffffu); }
__device__ __forceinline__ float bf2f(bf16_t b) { return __uint_as_float(((unsigned)b) << 16); }
__device__ __forceinline__ float bflo(unsigned w) { return __uint_as_float(w << 16); }
__device__ __forceinline__ float bfhi(unsigned w) { return __uint_as_float(w & 0xffff0000u); }
__device__ __forceinline__ float fsigmoid(float x) { return __builtin_amdgcn_rcpf(1.0f + __expf(-x)); }
__device__ __forceinline__ float gelu_t(float x) { const float z = 1.5957691216f * (x + 0.044715f * x * x * x); return x * __builtin_amdgcn_rcpf(1.0f + __expf(-z)); }
__device__ __forceinline__ float dpp_shr1(float v) { return __int_as_float(__builtin_amdgcn_update_dpp(__float_as_int(v), __float_as_int(v), 0x111, 0xf, 0xf, false)); }
__device__ __forceinline__ float dpp_shl1(float v) { return __int_as_float(__builtin_amdgcn_update_dpp(__float_as_int(v), __float_as_int(v), 0x101, 0xf, 0xf, false)); }
__device__ __forceinline__ void seq_info(int s, int& rb, int& L) { if (s < 16) { rb = s * LP; L = LP; } else { rb = RP + (s - 16) * LS; L = LS; } }
__device__ __forceinline__ void row_pos(int r, int& pos, int& len) { if (r < RP) { pos = r % LP; len = LP; } else { pos = (r - RP) % LS; len = LS; } }
__device__ __forceinline__ float rowscale(const float* rss, int row) {
    const f32x4* p = (const f32x4*)(rss + (size_t)row * 16);
    const f32x4 a = p[0], b = p[1], c = p[2], d = p[3];
    const float s = ((a[0] + a[1]) + (a[2] + a[3])) + ((b[0] + b[1]) + (b[2] + b[3])) + ((c[0] + c[1]) + (c[2] + c[3])) + ((d[0] + d[1]) + (d[2] + d[3]));
    return rsqrtf(s * (1.0f / 1024.0f) + EPS);
}

namespace pg8 {
constexpr int BM = 256, BK = 64, HALF = 128, HTB = HALF * BK * 2, NXCD = 8, WGM = 8;
__device__ __forceinline__ int lds_byte(int r, int c) { const int st = (r >> 4) * 2 + (c >> 5), rr = r & 15, cc = c & 31, ob = rr * 64 + cc * 2; return st * 1024 + (ob ^ (((ob >> 9) & 1) << 5)); }
__device__ __forceinline__ void stage_rc(int b, int& Rr, int& C) { const int st = b / 1024, sb = b % 1024, swz = sb ^ (((sb >> 9) & 1) << 5); Rr = (st >> 1) * 16 + swz / 64; C = (st & 1) * 32 + (swz % 64) / 2; }
__device__ __forceinline__ int perm32(int rho) { const int n = rho >> 4, i = rho & 15; return 8 * (i >> 2) + 4 * n + (i & 3); }
struct Unit { int pm, pn; };
struct StaticOrder {
    int nM, nN, nwg, G, c;
    __device__ void init(int nM_, int nN_, int G_, int c_) { nM = nM_; nN = nN_; nwg = nM * nN; G = G_; c = c_; }
    __device__ bool next(int i, Unit& u) const {
        const long L = (long)i * G + c; if (L >= nwg) return false;
        int wgid = (int)L; { const int q = nwg / NXCD, r = nwg % NXCD, xcd = wgid % NXCD, off = wgid / NXCD; wgid = (xcd < r ? xcd * (q + 1) : r * (q + 1) + (xcd - r) * q) + off; }
        const int nig = WGM * nN, gid = wgid / nig, fm = gid * WGM, gsz = (nM - fm) < WGM ? (nM - fm) : WGM;
        u.pm = fm + ((wgid % nig) % gsz); u.pn = (wgid % nig) / gsz; return true;
    }
};
struct GemmDesc { const char* A; const char* A2; int pm_split; int lda; const char* Bt; int K; int ablk; };

template <bool CONV, class Epi>
__device__ __forceinline__ void gemm_phase(LAS unsigned char* lds, const GemmDesc g, const StaticOrder& S, const Epi& E) {
    int tid = threadIdx.x; asm volatile("" : "+v"(tid));
    const int wid = __builtin_amdgcn_readfirstlane(tid >> 6), lane = tid & 63, wr = wid >> 2, wc = wid & 3, fr = lane & 15, fq = lane >> 4;
    const int K = g.K, nt = K / BK;
    int voffA[2], voffB[2];
#pragma unroll
    for (int i = 0; i < 2; ++i) { int Rr, C; stage_rc(tid * 16 + i * 8192, Rr, C);
        const int ra = CONV ? (62 * (Rr >> 6) - 1 + 4 * (Rr & 15) + ((Rr >> 4) & 3)) : Rr;
        const int Rb = Epi::WIDE ? ((Rr >> 5) * 64 + ((Rr >> 2) & 3) * 16 + ((Rr >> 4) & 1) * 4 + (Rr & 3)) : ((Rr & ~31) + perm32(Rr & 31));
        voffA[i] = g.ablk ? (((C >> 4) * MP + ra) * 16 + (C & 15)) * 2 : (ra * g.lda + C) * 2; voffB[i] = (Rb * K + C) * 2; }
    const long kstep = (long)(BK * 2);
    const long kstepA = g.ablk ? 4L * MP * 32 : kstep;
    const long hstepA = g.ablk ? (long)HALF * 32 : (long)(CONV ? 124 : HALF) * g.lda * 2, tstepA = 2 * hstepA;
    const long hstepB = (long)(Epi::WIDE ? 8 : HALF) * K * 2, tstepB = 2L * HALF * K * 2;
    const unsigned ldsw = (unsigned)wid * 1024u;
    const int aoff = lds_byte(wr * 64 + fr, fq * 8), boff = lds_byte(wc * 32 + fr, fq * 8);
#define PG8_SA(b, h) (((b) * 2 + (h)) * HTB)
#define PG8_SB(b, h) ((4 + (b) * 2 + (h)) * HTB)
#define PG8_STAGE(bufoff, gbase, voff) do { _Pragma("unroll") for (int _i = 0; _i < 2; ++_i) \
        __builtin_amdgcn_global_load_lds((const unsigned*)((const char*)(gbase) + (voff)[_i]), (LAS unsigned*)(lds + (bufoff) + ldsw + _i * 8192), 16, 0, 0); } while (0)
#define PG8_LDA(dst, b, h) do { _Pragma("unroll") for (int m = 0; m < 4; ++m) _Pragma("unroll") for (int k = 0; k < 2; ++k) dst[m][k] = *(const LAS bf16x8*)(lds + PG8_SA(b, h) + aoff + m * 2048 + k * 1024); } while (0)
#define PG8_LDB(dst, b, h) do { _Pragma("unroll") for (int n = 0; n < 2; ++n) _Pragma("unroll") for (int k = 0; k < 2; ++k) dst[n][k] = *(const LAS bf16x8*)(lds + PG8_SB(b, h) + boff + n * 2048 + k * 1024); } while (0)
#define PG8_MMA(ai, bj, At, Bt) do { __builtin_amdgcn_s_setprio(1); _Pragma("unroll") for (int m = 0; m < 4; ++m) _Pragma("unroll") for (int n = 0; n < 2; ++n) _Pragma("unroll") for (int k = 0; k < 2; ++k) \
        acc[ai][bj][m][n] = __builtin_amdgcn_mfma_f32_16x16x32_bf16(Bt[n][k], At[m][k], acc[ai][bj][m][n], 0, 0, 0); __builtin_amdgcn_s_setprio(0); } while (0)
#define PG8_WAIT_V(n) asm volatile("s_waitcnt vmcnt(" #n ")" ::: "memory")
#define PG8_WAIT_L(n) asm volatile("s_waitcnt lgkmcnt(" #n ")" ::: "memory")
#define PG8_BAR __builtin_amdgcn_s_barrier()
#define PG8_SCHED __builtin_amdgcn_sched_barrier(0)
#define PG8_ABASE(pm) ((pm) < g.pm_split ? g.A + (long)(pm) * tstepA : g.A2 + (long)((pm) - g.pm_split) * tstepA)
    Unit cur, nxt; int ui = 0;
    if (!S.next(0, cur)) return;
    f32x4 acc[2][2][4][2];
#pragma unroll
    for (int a = 0; a < 2; ++a)
#pragma unroll
        for (int b = 0; b < 2; ++b)
#pragma unroll
            for (int m = 0; m < 4; ++m)
#pragma unroll
                for (int n = 0; n < 2; ++n) acc[a][b][m][n] = (f32x4){0.f, 0.f, 0.f, 0.f};
    bf16x8 At[4][2], B0[2][2], B1[2][2];
    const char* cA = PG8_ABASE(cur.pm); const char* cB = g.Bt + (long)cur.pn * tstepB;
    PG8_STAGE(PG8_SB(0, 0), cB, voffB); PG8_STAGE(PG8_SA(0, 0), cA, voffA); PG8_STAGE(PG8_SB(0, 1), cB + hstepB, voffB); PG8_STAGE(PG8_SA(0, 1), cA + hstepA, voffA);
    if (wr == 1) PG8_BAR;
    PG8_WAIT_V(4); PG8_BAR;
    PG8_STAGE(PG8_SB(1, 0), cB + kstep, voffB); PG8_STAGE(PG8_SA(1, 0), cA + kstepA, voffA); PG8_STAGE(PG8_SB(1, 1), cB + hstepB + kstep, voffB);
    PG8_WAIT_V(6); PG8_BAR;
    for (;;) {
        const bool has_next = S.next(ui + 1, nxt);
        const char* nA = has_next ? PG8_ABASE(nxt.pm) : cA; const char* nB = has_next ? g.Bt + (long)nxt.pn * tstepB : cB;
        LAS unsigned char* aux = lds + AUX_OFF + (ui & 1) * AUXSZ;
        E.prefetch(aux, cur, tid);
        for (int t = 0; t < nt; t += 2) {
            const bool last = (t == nt - 2);
            const char* a1 = cA + (long)(t + 1) * kstepA;
            const char* a2 = last ? nA : cA + (long)(t + 2) * kstepA; const char* b2 = last ? nB : cB + (long)(t + 2) * kstep;
            const char* a3 = a2 + kstepA; const char* b3 = b2 + kstep;
            PG8_LDB(B0, 0, 0); PG8_SCHED; PG8_LDA(At, 0, 0); PG8_STAGE(PG8_SA(1, 1), a1 + hstepA, voffA);
            PG8_WAIT_L(8); PG8_BAR; PG8_WAIT_L(0); PG8_MMA(0, 0, At, B0); PG8_BAR; PG8_SCHED;
            PG8_LDB(B1, 0, 1); PG8_STAGE(PG8_SB(0, 0), b2, voffB);
            PG8_BAR; PG8_WAIT_L(0); PG8_MMA(0, 1, At, B1); PG8_BAR;
            PG8_LDA(At, 0, 1); PG8_STAGE(PG8_SA(0, 0), a2, voffA);
            PG8_BAR; PG8_WAIT_L(0); PG8_MMA(1, 0, At, B0); PG8_BAR; PG8_SCHED;
            PG8_STAGE(PG8_SB(0, 1), b2 + hstepB, voffB);
            PG8_WAIT_V(6); PG8_BAR; PG8_MMA(1, 1, At, B1); PG8_BAR;
            PG8_LDB(B0, 1, 0); PG8_SCHED; PG8_LDA(At, 1, 0); PG8_STAGE(PG8_SA(0, 1), a2 + hstepA, voffA);
            PG8_WAIT_L(8); PG8_BAR; PG8_WAIT_L(0); PG8_MMA(0, 0, At, B0); PG8_BAR; PG8_SCHED;
            PG8_LDB(B1, 1, 1); PG8_STAGE(PG8_SB(1, 0), b3, voffB);
            PG8_BAR; PG8_WAIT_L(0); PG8_MMA(0, 1, At, B1); PG8_BAR;
            PG8_LDA(At, 1, 1); PG8_STAGE(PG8_SA(1, 0), a3, voffA);
            PG8_BAR; PG8_WAIT_L(0); PG8_MMA(1, 0, At, B0); PG8_BAR; PG8_SCHED;
            PG8_STAGE(PG8_SB(1, 1), b3 + hstepB, voffB);
            PG8_WAIT_V(6); PG8_BAR; PG8_MMA(1, 1, At, B1); PG8_BAR;
        }
        E(acc, cur, wr, wc, fr, fq, aux);
        if (!has_next) break;
#pragma unroll
        for (int a = 0; a < 2; ++a)
#pragma unroll
            for (int b = 0; b < 2; ++b)
#pragma unroll
                for (int m = 0; m < 4; ++m)
#pragma unroll
                    for (int n = 0; n < 2; ++n) acc[a][b][m][n] = (f32x4){0.f, 0.f, 0.f, 0.f};
        cur = nxt; cA = nA; cB = nB; ++ui;
    }
    PG8_WAIT_V(0);
    if (wr == 0) PG8_BAR;
    PG8_BAR;
#undef PG8_SA
#undef PG8_SB
#undef PG8_STAGE
#undef PG8_LDA
#undef PG8_LDB
#undef PG8_MMA
#undef PG8_WAIT_V
#undef PG8_WAIT_L
#undef PG8_BAR
#undef PG8_SCHED
#undef PG8_ABASE
}
}

typedef f32x4 AccT[2][2][4][2];

struct EpiScale {
    static constexpr bool WIDE = true;
    bf16_t* out; int ldc; const float* rss; bf16_t* vt; int vt_pn; bf16_t* kt;
    __device__ __forceinline__ void prefetch(LAS unsigned char* aux, const pg8::Unit& u, int tid) const {
        if (tid < 256) ((LAS float*)aux)[tid] = rowscale(rss, u.pm * 256 + tid);
    }
    __device__ __forceinline__ void operator()(AccT& acc, const pg8::Unit& u, int wr, int wc, int fr, int fq, LAS unsigned char* aux) const {
#pragma unroll
        for (int ai = 0; ai < 2; ++ai)
#pragma unroll
            for (int m = 0; m < 4; ++m) {
                const int rl = ai * 128 + wr * 64 + m * 16 + fr, row = u.pm * 256 + rl;
                const float rs = ((const LAS float*)aux)[rl];
                if (u.pn < vt_pn - 1) {
#pragma unroll
                    for (int bj = 0; bj < 2; ++bj) { const int col = u.pn * 256 + wc * 64 + 16 * fq + 8 * bj; const f32x4 v0 = acc[ai][bj][m][0] * rs, v1 = acc[ai][bj][m][1] * rs;
                        u32x4 w; w.x = pack2(v0[0], v0[1]); w.y = pack2(v0[2], v0[3]); w.z = pack2(v1[0], v1[1]); w.w = pack2(v1[2], v1[3]); __builtin_nontemporal_store(w, (u32x4*)(out + (size_t)row * ldc + col)); }
                } else if (u.pn == vt_pn - 1) {
#pragma unroll
                    for (int bj = 0; bj < 2; ++bj) { const int dt_ = wc * 64 + 16 * fq + 8 * bj; const f32x4 v0 = acc[ai][bj][m][0] * rs, v1 = acc[ai][bj][m][1] * rs;
                        u32x4 w; w.x = pack2(v0[0], v0[1]); w.y = pack2(v0[2], v0[3]); w.z = pack2(v1[0], v1[1]); w.w = pack2(v1[2], v1[3]);
                        *(u32x4*)(kt + ((((size_t)(dt_ >> 6) * (MP / 16) + (row >> 4)) * 4 + ((dt_ & 63) >> 4)) * 16 + (row & 15)) * 16 + (dt_ & 8)) = w; }
                } else {
#pragma unroll
                    for (int bj = 0; bj < 2; ++bj)
#pragma unroll
                        for (int n = 0; n < 2; ++n) { const int d = (u.pn - vt_pn) * 256 + wc * 64 + 16 * fq + 8 * bj + 4 * n; const f32x4 v = acc[ai][bj][m][n] * rs;
#pragma unroll
                            for (int e = 0; e < 4; ++e) { const int dt_ = d + e; vt[((size_t)((dt_ >> 6) * (MP / 16) + (row >> 4)) * 64 + (dt_ & 63)) * 16 + (row & 15)] = f2bf(v[e]); } }
                }
            }
    }
};

struct EpiGlu {
    static constexpr bool WIDE = true;
    const bf16_t* yin; bf16_t* out; const float* bias;
    __device__ __forceinline__ void prefetch(LAS unsigned char*, const pg8::Unit&, int) const {}
    __device__ __forceinline__ void operator()(AccT& acc, const pg8::Unit& u, int wr, int wc, int fr, int fq, LAS unsigned char*) const {
#pragma unroll
        for (int ai = 0; ai < 2; ++ai)
#pragma unroll
            for (int m = 0; m < 4; ++m) {
                const int row = u.pm * 256 + ai * 128 + wr * 64 + m * 16 + fr;
#pragma unroll
                for (int bj = 0; bj < 2; ++bj) { const int col = u.pn * 256 + wc * 64 + 16 * fq + 8 * bj;
                    const size_t boff = ((size_t)(col >> 4) * MP + row) * 16 + (col & 15);
                    const u32x4 yw = *(const u32x4*)(yin + boff); const f32x4 b0 = *(const f32x4*)(bias + col), b1 = *(const f32x4*)(bias + col + 4);
                    const f32x4 a0 = acc[ai][bj][m][0], a1 = acc[ai][bj][m][1];
                    u32x4 w;
                    w.x = pack2(bflo(yw.x) * fsigmoid(a0[0] + b0[0]), bfhi(yw.x) * fsigmoid(a0[1] + b0[1])); w.y = pack2(bflo(yw.y) * fsigmoid(a0[2] + b0[2]), bfhi(yw.y) * fsigmoid(a0[3] + b0[3]));
                    w.z = pack2(bflo(yw.z) * fsigmoid(a1[0] + b1[0]), bfhi(yw.z) * fsigmoid(a1[1] + b1[1])); w.w = pack2(bflo(yw.w) * fsigmoid(a1[2] + b1[2]), bfhi(yw.w) * fsigmoid(a1[3] + b1[3]));
                    __builtin_nontemporal_store(w, (u32x4*)(out + boff)); }
            }
    }
};

struct EpiRes {
    static constexpr bool WIDE = true;
    bf16_t* H; float* rss; int compact;
    __device__ __forceinline__ void prefetch(LAS unsigned char*, const pg8::Unit&, int) const {}
    __device__ __forceinline__ void operator()(AccT& acc, const pg8::Unit& u, int wr, int wc, int fr, int fq, LAS unsigned char*) const {
#pragma unroll
        for (int ai = 0; ai < 2; ++ai)
#pragma unroll
            for (int m = 0; m < 4; ++m) {
                int row = u.pm * 256 + ai * 128 + wr * 64 + m * 16 + fr; float ss = 0.f;
                if (compact) row = (row < 32768) ? row + 16 * ((row >> 11) + 1) : row + 16 * (17 + ((row - 32768) >> 13));
#pragma unroll
                for (int bj = 0; bj < 2; ++bj) { const int col = u.pn * 256 + wc * 64 + 16 * fq + 8 * bj; bf16_t* hp = H + (size_t)row * 1024 + col;
                    const u32x4 hw = *(const u32x4*)hp; const f32x4 a0 = acc[ai][bj][m][0], a1 = acc[ai][bj][m][1];
                    const float v0 = bflo(hw.x) + a0[0], v1 = bfhi(hw.x) + a0[1], v2 = bflo(hw.y) + a0[2], v3 = bfhi(hw.y) + a0[3];
                    const float v4 = bflo(hw.z) + a1[0], v5 = bfhi(hw.z) + a1[1], v6 = bflo(hw.w) + a1[2], v7 = bfhi(hw.w) + a1[3];
                    ss += ((v0 * v0 + v1 * v1) + (v2 * v2 + v3 * v3)) + ((v4 * v4 + v5 * v5) + (v6 * v6 + v7 * v7));
                    u32x4 w; w.x = pack2(v0, v1); w.y = pack2(v2, v3); w.z = pack2(v4, v5); w.w = pack2(v6, v7); __builtin_nontemporal_store(w, (u32x4*)hp); }
                ss += __shfl_xor(ss, 16); ss += __shfl_xor(ss, 32);
                if (fq == 0) rss[(size_t)row * 16 + u.pn * 4 + wc] = ss;
            }
    }
};

struct EpiUp {
    static constexpr bool WIDE = false;
    bf16_t* act1; bf16_t* act2; const float* rss; const float* cw; const float* cb; int compact;
    __device__ __forceinline__ void prefetch(LAS unsigned char* aux, const pg8::Unit& u, int tid) const {
        if (tid < 256) {
            const int t = u.pm * 248 + 62 * (tid >> 6) - 1 + 4 * (tid & 15) + ((tid >> 4) & 3);
            const int tc = t < 0 ? 0 : (t > MP - 1 ? MP - 1 : t);
            int pos, len; row_pos(tc, pos, len);
            ((LAS float*)aux)[tid] = rowscale(rss, tc);
            ((LAS unsigned*)aux)[256 + tid] = (pos == 0 ? 1u : 0u) | (pos == len - 1 ? 2u : 0u);
        } else {
            const int tt = tid - 256, kind = tt >> 5, c4 = (tt & 31) * 4, k3 = kind & 3;
            const float* srcp = (k3 == 3 ? cb : cw + k3 * 5632) + (kind >= 4 ? DFF : 0) + u.pn * 128 + c4;
            *(LAS f32x4*)(aux + 2048 + (kind * 128 + c4) * 4) = *(const f32x4*)srcp;
        }
    }
    __device__ __forceinline__ void operator()(AccT& acc, const pg8::Unit& u, int wr, int wc, int fr, int fq, LAS unsigned char* aux) const {
        float rs[2][4]; unsigned fl = 0;
#pragma unroll
        for (int ai = 0; ai < 2; ++ai)
#pragma unroll
            for (int m = 0; m < 4; ++m) { const int rl = ai * 128 + wr * 64 + m * 16 + fr; rs[ai][m] = ((const LAS float*)aux)[rl]; fl |= ((const LAS unsigned*)aux)[256 + rl] << ((ai * 4 + m) * 2); }
        const LAS float* cv = (const LAS float*)(aux + 2048);
#pragma unroll
        for (int n = 0; n < 2; ++n) {
            const int cl = wc * 32 + 8 * fq + 4 * n;
            const f32x4 wa0 = *(const LAS f32x4*)(cv + cl), wa1 = *(const LAS f32x4*)(cv + 128 + cl), wa2 = *(const LAS f32x4*)(cv + 256 + cl), ba = *(const LAS f32x4*)(cv + 384 + cl);
            const f32x4 wg0 = *(const LAS f32x4*)(cv + 512 + cl), wg1 = *(const LAS f32x4*)(cv + 640 + cl), wg2 = *(const LAS f32x4*)(cv + 768 + cl), bg = *(const LAS f32x4*)(cv + 896 + cl);
#pragma unroll
            for (int e2 = 0; e2 < 2; ++e2) {
                const int e0 = 2 * e2, e1 = e0 + 1;
                const f32v2 pwa0 = {wa0[e0], wa0[e1]}, pwa1 = {wa1[e0], wa1[e1]}, pwa2 = {wa2[e0], wa2[e1]}, pba = {ba[e0], ba[e1]};
                const f32v2 pwg0 = {wg0[e0], wg0[e1]}, pwg1 = {wg1[e0], wg1[e1]}, pwg2 = {wg2[e0], wg2[e1]}, pbg = {bg[e0], bg[e1]};
#pragma unroll
                for (int ai = 0; ai < 2; ++ai) {
                    f32v2 ua[4], ug[4];
#pragma unroll
                    for (int m = 0; m < 4; ++m) { const f32v2 a2 = {acc[ai][0][m][n][e0], acc[ai][0][m][n][e1]}, g2 = {acc[ai][1][m][n][e0], acc[ai][1][m][n][e1]}; ua[m] = a2 * rs[ai][m]; ug[m] = g2 * rs[ai][m]; }
                    const f32v2 pa = {dpp_shr1(ua[3].x), dpp_shr1(ua[3].y)}, pg = {dpp_shr1(ug[3].x), dpp_shr1(ug[3].y)};
                    const f32v2 na = {dpp_shl1(ua[0].x), dpp_shl1(ua[0].y)}, ng = {dpp_shl1(ug[0].x), dpp_shl1(ug[0].y)};
#pragma unroll
                    for (int m = 0; m < 4; ++m) {
                        const bool first = (fl >> ((ai * 4 + m) * 2)) & 1u, lastt = (fl >> ((ai * 4 + m) * 2 + 1)) & 1u;
                        f32v2 a_p = (m == 0) ? pa : ua[m == 0 ? 0 : m - 1], g_p = (m == 0) ? pg : ug[m == 0 ? 0 : m - 1];
                        f32v2 a_n = (m == 3) ? na : ua[m == 3 ? 3 : m + 1], g_n = (m == 3) ? ng : ug[m == 3 ? 3 : m + 1];
                        const f32v2 zz = {0.f, 0.f};
                        if (first) { a_p = zz; g_p = zz; }
                        if (lastt) { a_n = zz; g_n = zz; }
                        const f32v2 av = pwa0 * a_p + pwa1 * ua[m] + pwa2 * a_n + pba;
                        const f32v2 gv = pwg0 * g_p + pwg1 * ug[m] + pwg2 * g_n + pbg;
                        const f32v2 zexp = gv * (gv * gv * (-0.102943185f) + (-2.302208198f));
                        f32v2 den; den.x = 1.0f + __builtin_amdgcn_exp2f(zexp.x); den.y = 1.0f + __builtin_amdgcn_exp2f(zexp.y);
                        f32v2 sg; sg.x = __builtin_amdgcn_rcpf(den.x); sg.y = __builtin_amdgcn_rcpf(den.y);
                        f32v2 res = gv * sg * av; asm volatile("" : "+v"(res));
                        acc[ai][0][m][n][e0] = res.x; acc[ai][0][m][n][e1] = res.y;
                    }
                }
                __builtin_amdgcn_sched_barrier(0);
            }
        }
#pragma unroll
        for (int ai = 0; ai < 2; ++ai)
#pragma unroll
            for (int m = 0; m < 4; ++m) {
                const int i = 4 * fr + m; const int t = u.pm * 248 + 62 * (2 * ai + wr) - 1 + i;
                bool ok = (i >= 1 && i <= 62 && t < R); int tr = t;
                if (compact && ok) { int pos, sidx; if (t < RP) { sidx = t / LP; pos = t - sidx * LP; } else { const int t2 = t - RP; const int s2 = t2 / LS; pos = t2 - s2 * LS; sidx = 16 + s2; }
                    ok = (pos >= 16); tr = t - 16 * (sidx + 1); }
                if (ok) {
                    bf16_t* rowp = (tr < RSPLIT) ? act1 + (size_t)tr * DFF : act2 + (size_t)(tr - RSPLIT) * DFF;
                    const f32x4 v0 = acc[ai][0][m][0], v1 = acc[ai][0][m][1];
                    u32x4 w; w.x = pack2(v0[0], v0[1]); w.y = pack2(v0[2], v0[3]); w.z = pack2(v1[0], v1[1]); w.w = pack2(v1[2], v1[3]);
                    __builtin_nontemporal_store(w, (u32x4*)(rowp + u.pn * 128 + wc * 32 + 8 * fq));
                }
            }
    }
};

__device__ __forceinline__ const float* src_row(const Params& p, int r) {
    if (r < RP) { const int s = r / LP, pos = r - s * LP; return pos < 16 ? p.in[2] + pos * DM : p.in[0] + ((size_t)s * 2048 + pos - 16) * DM; }
    const int r2 = r - RP, s = r2 / LS, pos = r2 - s * LS; return pos < 16 ? p.in[2] + pos * DM : p.in[1] + ((size_t)s * 8192 + pos - 16) * DM;
}
__device__ __forceinline__ void cvt_w(bf16_t* dst, const float* src, int K, int N, const float* gk, int nscale_lim, bool upperm, long t0, long nth) {
    const long total = (long)N * (K / 8);
    for (long t = t0; t < total; t += nth) {
        const int n = (int)(t % N), kb = (int)(t / N);
        const int sn = upperm ? (((n & 255) < 128) ? (n >> 8) * 128 + (n & 127) : DFF + (n >> 8) * 128 + (n & 127)) : n;
        const float sc = n < nscale_lim ? 0.125f * 1.4426950408889634f : 1.0f;
        float v[8];
#pragma unroll
        for (int j = 0; j < 8; ++j) { const int k = kb * 8 + j; v[j] = src[(size_t)k * N + sn] * (gk ? gk[k] : 1.0f) * sc; }
        u32x4 w; w.x = pack2(v[0], v[1]); w.y = pack2(v[2], v[3]); w.z = pack2(v[4], v[5]); w.w = pack2(v[6], v[7]);
        *(u32x4*)(dst + (size_t)n * K + kb * 8) = w;
    }
}
__device__ __forceinline__ void phase_prep(const Params& p) {
    int tid = threadIdx.x; asm volatile("" : "+v"(tid)); const int lane = tid & 63, wid = tid >> 6;
    const int gw = blockIdx.x * 8 + wid, nw = gridDim.x * 8;
    bf16_t* H = (bf16_t*)(p.ws + OFF_HPAD) + 8 * 1024; float* rss = (float*)(p.ws + OFF_RSS);
    for (int rr0 = gw; rr0 < MP + 8; rr0 += 2 * nw) {
        f32x4 v[2][4]; bool ok[2]; int rws[2];
#pragma unroll
        for (int j = 0; j < 2; ++j) {
            const int rr = rr0 + j * nw; const int r = rr - 8; rws[j] = r;
            ok[j] = (rr < MP + 8) && (r >= 0) && (r < R);
            if (ok[j]) { const float* src = src_row(p, r);
#pragma unroll
                for (int i = 0; i < 4; ++i) v[j][i] = __builtin_nontemporal_load((const f32x4*)(src + i * 256 + lane * 4)); }
            else {
#pragma unroll
                for (int i = 0; i < 4; ++i) v[j][i] = (f32x4){0.f, 0.f, 0.f, 0.f}; }
        }
#pragma unroll
        for (int j = 0; j < 2; ++j) {
            const int rr = rr0 + j * nw; if (rr >= MP + 8) continue;
            const int r = rws[j]; bf16_t* hrow = H + (long)r * 1024; float ss = 0.f;
#pragma unroll
            for (int i = 0; i < 4; ++i) { const f32x4 x = v[j][i]; ss += (x[0] * x[0] + x[1] * x[1]) + (x[2] * x[2] + x[3] * x[3]);
                u32x2 w; w.x = pack2(x[0], x[1]); w.y = pack2(x[2], x[3]); *(u32x2*)(hrow + i * 256 + lane * 4) = w; }
#pragma unroll
            for (int o = 32; o >= 1; o >>= 1) ss += __shfl_xor(ss, o);
            if (r >= 0 && lane < 16) rss[(size_t)r * 16 + lane] = (lane == 0) ? ss : 0.f;
        }
    }
    unsigned char* ws = p.ws;
    cvt_w((bf16_t*)(ws + OFF_WIN), p.in[6], 1024, 1536, p.in[3], 0, false, (long)blockIdx.x * blockDim.x + tid, (long)gridDim.x * blockDim.x);
}
__device__ __forceinline__ void cvt_rest(const Params& p, long t0, long nth) {
    unsigned char* ws = p.ws;
    cvt_w((bf16_t*)(ws + OFF_WGLU), p.in[15], 512, 512, nullptr, 0, false, t0, nth);
    cvt_w((bf16_t*)(ws + OFF_WOUT), p.in[24], 1024, 1024, nullptr, 0, false, t0, nth);
    cvt_w((bf16_t*)(ws + OFF_WUP0), p.in[28], 1024, 5632, p.in[4], 0, true, t0, nth);
    cvt_w((bf16_t*)(ws + OFF_WDN0), p.in[31], 2816, 1024, nullptr, 0, false, t0, nth);
    cvt_w((bf16_t*)(ws + OFF_WQKV), p.in[25], 1024, 1536, p.in[3] + 1024, 1024, false, t0, nth);
    cvt_w((bf16_t*)(ws + OFF_WO), p.in[26], 1024, 1024, nullptr, 0, false, t0, nth);
    cvt_w((bf16_t*)(ws + OFF_WUP1), p.in[28] + (size_t)1024 * 5632, 1024, 5632, p.in[4] + 1024, 0, true, t0, nth);
    cvt_w((bf16_t*)(ws + OFF_WDN1), p.in[31] + (size_t)2816 * 1024, 2816, 1024, nullptr, 0, false, t0, nth);
}

constexpr int WLDS = 18944;
__device__ __forceinline__ void s5_unit(const Params& p, LAS unsigned char* wl, int s, int d, int g, int lane, const bf16_t* Z, bf16_t* outb) {
    asm volatile("" : "+v"(lane));
    int rb, L; seq_info(s, rb, L);
    const int col = lane & 15, q = lane >> 4, dg = d * 32 + g;
    const float* lam_re = p.in[7]; const float* lam_im = p.in[8]; const float* b_re = p.in[10]; const float* b_im = p.in[11]; const float* c_re = p.in[12]; const float* c_im = p.in[13];
    const float dt = expf(p.in[9][dg]);
    float lbr, lbi;
    { const float lr = fminf(lam_re[dg * 64 + lane], -1e-4f), li = lam_im[dg * 64 + lane]; const float a = lr * dt, b = li * dt, e = expf(a); float sb, cb; sincosf(b, &sb, &cb); lbr = e * cb; lbi = e * sb; }
    bf16x4 Bf[8]; bf16x8 Cf[4];
#pragma unroll
    for (int i = 0; i < 8; ++i) {
        const int kp = 16 * i + col, n = kp & 63, part = kp >> 6;
        const float lr = fminf(lam_re[dg * 64 + n], -1e-4f), li = lam_im[dg * 64 + n]; const float a = lr * dt, b = li * dt, e = expf(a); float sb, cb; sincosf(b, &sb, &cb);
        const float sh = sinf(0.5f * b); const float nr = expm1f(a) * cb - 2.0f * sh * sh, ni = e * sb; const float inv = 1.0f / (lr * lr + li * li);
        const float cr = (nr * lr + ni * li) * inv, ci = (ni * lr - nr * li) * inv;
#pragma unroll
        for (int j = 0; j < 4; ++j) {
            const int c = 4 * q + j; const float bre = b_re[(size_t)(dg * 64 + n) * 16 + c], bim = b_im[(size_t)(dg * 64 + n) * 16 + c];
            Bf[i][j] = (short)f2bf((part == 0) ? cr * bre - ci * bim : cr * bim + ci * bre);
        }
    }
#pragma unroll
    for (int kk = 0; kk < 4; ++kk)
#pragma unroll
        for (int j = 0; j < 8; ++j) { const int kp = 32 * kk + 8 * q + j, n = kp >> 1; const float val = (kp & 1) ? -c_im[(size_t)(dg * 16 + col) * 64 + n] : c_re[(size_t)(dg * 16 + col) * 64 + n]; Cf[kk][j] = (short)f2bf(val); }
    LAS float* BUt = (LAS float*)wl;
    LAS bf16_t* Xb = (LAS bf16_t*)(wl + 10240);
    float xr = 0.f, xi = 0.f;
    const int nch = L / 16;
    const bf16x4 zero4 = {0, 0, 0, 0};
    const bf16_t* zg = Z + (size_t)rb * 1536 + 16 * g + 4 * q;
#define S5_FRAG(dst, CH) do { dst = zero4; if ((CH) < nch) { const int _tau = (CH) * 16 + col; dst = *(const bf16x4*)(zg + (size_t)(d ? (L - 1 - _tau) : _tau) * 1536); } } while (0)
#define S5_CPROJ(CH) do { const LAS bf16_t* _X = Xb + ((CH) & 1) * 2176; f32x4 y = {0.f, 0.f, 0.f, 0.f}; \
        _Pragma("unroll") for (int kk = 0; kk < 4; ++kk) { const bf16x8 xa = *(const LAS bf16x8*)(_X + col * 136 + 32 * kk + 8 * q); y = __builtin_amdgcn_mfma_f32_16x16x32_bf16(xa, Cf[kk], y, 0, 0, 0); } \
        _Pragma("unroll") for (int r = 0; r < 4; ++r) { const int tau = (CH) * 16 + 4 * q + r; const int pos = d ? (L - 1 - tau) : tau; outb[((size_t)g * MP + rb + pos) * 16 + col] = f2bf(y[r]); } } while (0)
    bf16x4 ring[3];
    { bf16x4 a0; S5_FRAG(a0, 0);
#pragma unroll
      for (int i = 0; i < 8; ++i) { const f32x4 bu = __builtin_amdgcn_mfma_f32_16x16x16bf16_1k(a0, Bf[i], (f32x4){0.f, 0.f, 0.f, 0.f}, 0, 0, 0); *(LAS f32x4*)(BUt + (16 * i + col) * 20 + 4 * q) = bu; }
      S5_FRAG(ring[1], 1); S5_FRAG(ring[2], 2); S5_FRAG(ring[0], 3); }
    asm volatile("s_waitcnt lgkmcnt(0)" ::: "memory");
    for (int ch3 = 0; ch3 < nch; ch3 += 3) {
#pragma unroll
      for (int k3 = 0; k3 < 3; ++k3) {
        const int ch = ch3 + k3;
        f32x4 re4[4], im4[4];
#pragma unroll
        for (int v = 0; v < 4; ++v) { re4[v] = *(const LAS f32x4*)(BUt + lane * 20 + 4 * v); im4[v] = *(const LAS f32x4*)(BUt + (64 + lane) * 20 + 4 * v); }
        asm volatile("s_waitcnt lgkmcnt(0)" ::: "memory");
        f32x4 bun[8];
        const bool more = (ch + 1 < nch);
        if (more) {
            const bf16x4 a = ring[(k3 + 1) % 3];
#pragma unroll
            for (int i = 0; i < 8; ++i) bun[i] = __builtin_amdgcn_mfma_f32_16x16x16bf16_1k(a, Bf[i], (f32x4){0.f, 0.f, 0.f, 0.f}, 0, 0, 0);
            S5_FRAG(ring[(k3 + 1) % 3], ch + 4);
        }
        if (ch > 0) S5_CPROJ(ch - 1);
        LAS bf16_t* X = Xb + (ch & 1) * 2176;
#pragma unroll
        for (int t = 0; t < 16; ++t) {
            const float re = re4[t >> 2][t & 3], im = im4[t >> 2][t & 3];
            const float nxr = lbr * xr - lbi * xi + re, nxi = lbr * xi + lbi * xr + im; xr = nxr; xi = nxi;
            *(LAS unsigned*)(X + t * 136 + 2 * lane) = pack2(xr, xi);
        }
        if (more) {
#pragma unroll
            for (int i = 0; i < 8; ++i) *(LAS f32x4*)(BUt + (16 * i + col) * 20 + 4 * q) = bun[i];
        }
        asm volatile("s_waitcnt lgkmcnt(0)" ::: "memory");
      }
    }
    S5_CPROJ(nch - 1);
    asm volatile("s_waitcnt lgkmcnt(0)" ::: "memory");
#undef S5_FRAG
#undef S5_CPROJ
}

__device__ __forceinline__ void lru_unit(const Params& p, LAS unsigned char* wl, int s, int d, int hb, int nt, int lane, const bf16_t* Z, bf16_t* outb) {
    asm volatile("" : "+v"(lane));
    int rb, L; seq_info(s, rb, L);
    const int col = lane & 15, q = lane >> 4;
    const float* cwp = p.in[17]; const float* cbp = p.in[18];
    const float* Wr = p.in[19] + (size_t)(d * 8 + hb) * 4096; const float* Wi = p.in[21] + (size_t)(d * 8 + hb) * 4096;
    const int no = 16 * nt + col, cho = 64 * hb + no;
    float br = p.in[20][d * 512 + cho], bi = p.in[22][d * 512 + cho];
#pragma unroll 4
    for (int k = 0; k < 64; ++k) { const float cbk = cbp[64 * hb + k]; br += cbk * Wr[k * 64 + no]; bi += cbk * Wi[k * 64 + no]; }
    const float sp = log1pf(expf(-p.in[23][d * 512 + cho]));
    const float cw0 = cwp[cho], cw1 = cwp[512 + cho], cw2 = cwp[1024 + cho], cw3 = cwp[1536 + cho], cb0 = cbp[cho];
    bf16x8 WfR[4][2], WfI[4][2];
#pragma unroll
    for (int j = 0; j < 4; ++j)
#pragma unroll
        for (int kk = 0; kk < 2; ++kk) {
            float wr8[8], wi8[8];
#pragma unroll
            for (int e = 0; e < 8; ++e) { const int k = 32 * kk + 8 * q + e; const float c = cwp[j * 512 + 64 * hb + k]; wr8[e] = c * Wr[k * 64 + no]; wi8[e] = c * Wi[k * 64 + no]; }
            u32x4 a, b; a.x = pack2(wr8[0], wr8[1]); a.y = pack2(wr8[2], wr8[3]); a.z = pack2(wr8[4], wr8[5]); a.w = pack2(wr8[6], wr8[7]);
            b.x = pack2(wi8[0], wi8[1]); b.y = pack2(wi8[2], wi8[3]); b.z = pack2(wi8[4], wi8[5]); b.w = pack2(wi8[6], wi8[7]);
            WfR[j][kk] = __builtin_bit_cast(bf16x8, a); WfI[j][kk] = __builtin_bit_cast(bf16x8, b);
        }
    float carry = 0.f;
    const int nch = L / 16;
    const bf16_t* zrow = Z + (size_t)rb * 1536 + 512 + 64 * hb;
#define LRU_LOAD(dst, CH) do { const int _plo = d ? (L - 16 - 16 * (CH)) : 16 * (CH); \
        _Pragma("unroll") for (int i = 0; i < 3; ++i) { const int pc = lane + 64 * i; const int pp = _plo - 2 + (pc >> 3); u32x4 v = {0u, 0u, 0u, 0u}; \
            if ((CH) < nch && pc < 152 && pp >= 0 && pp < L) v = *(const u32x4*)(zrow + (size_t)pp * 1536 + (pc & 7) * 8); dst[i] = v; } } while (0)
#define LRU_TILE_WRITE(CH, SLOT) do { LAS unsigned char* _T = wl + ((CH) & 1) * 2816; \
        _Pragma("unroll") for (int i = 0; i < 3; ++i) { const int pc = lane + 64 * i; if (pc < 152) *(LAS u32x4*)(_T + (pc >> 3) * 144 + (pc & 7) * 16) = ring[SLOT][i]; } } while (0)
#define LRU_MFMA(CH, RO, IO) do { const LAS unsigned char* _T = wl + ((CH) & 1) * 2816; const int _tau0 = (CH) * 16; const int _PLO = d ? (L - 16 - _tau0) : _tau0; \
        const int _posc = d ? (L - 1 - (_tau0 + col)) : (_tau0 + col); RO = (f32x4){0.f, 0.f, 0.f, 0.f}; IO = (f32x4){0.f, 0.f, 0.f, 0.f}; \
        _Pragma("unroll") for (int j = 0; j < 4; ++j) _Pragma("unroll") for (int kk = 0; kk < 2; ++kk) { const bf16x8 af = *(const LAS bf16x8*)(_T + (_posc - _PLO + j) * 144 + kk * 64 + q * 16); \
            RO = __builtin_amdgcn_mfma_f32_16x16x32_bf16(af, WfR[j][kk], RO, 0, 0, 0); IO = __builtin_amdgcn_mfma_f32_16x16x32_bf16(af, WfI[j][kk], IO, 0, 0, 0); } } while (0)
    u32x4 ring[3][3];
    LRU_LOAD(ring[0], 0); LRU_LOAD(ring[1], 1); LRU_LOAD(ring[2], 2);
    f32x4 Rg, Ig;
    LRU_TILE_WRITE(0, 0); LRU_LOAD(ring[0], 3);
    asm volatile("s_waitcnt lgkmcnt(0)" ::: "memory");
    LRU_MFMA(0, Rg, Ig);
    for (int ch3 = 0; ch3 < nch; ch3 += 3) {
#pragma unroll
      for (int k3 = 0; k3 < 3; ++k3) {
        const int ch = ch3 + k3;
        const int tau0 = ch * 16;
        const int PLO = d ? (L - 16 - tau0) : tau0;
        const LAS unsigned char* T = wl + (ch & 1) * 2816;
        const bool more = (ch + 1 < nch);
        if (more) { LRU_TILE_WRITE(ch + 1, (k3 + 1) % 3); LRU_LOAD(ring[(k3 + 1) % 3], ch + 4); }
        const int ploq = d ? (L - 4 - tau0 - 4 * q) : (tau0 + 4 * q);
        float xw[7];
#pragma unroll
        for (int i = 0; i < 7; ++i) xw[i] = bf2f(*(const LAS bf16_t*)(T + (ploq - PLO + i) * 144 + no * 2));
        asm volatile("s_waitcnt lgkmcnt(0)" ::: "memory");
        f32x4 Rn = {0.f, 0.f, 0.f, 0.f}, In = {0.f, 0.f, 0.f, 0.f};
        if (more) LRU_MFMA(ch + 1, Rn, In);
        float xcp[4];
#pragma unroll
        for (int i = 0; i < 4; ++i) xcp[i] = cb0 + cw0 * xw[i] + cw1 * xw[i + 1] + cw2 * xw[i + 2] + cw3 * xw[i + 3];
        float av[4], bv[4];
#pragma unroll
        for (int r = 0; r < 4; ++r) {
            const float xcv = d ? xcp[3 - r] : xcp[r];
            const float e1 = __expf(-(Rg[r] + br)), e2 = __expf(-(Ig[r] + bi));
            const float inv = __builtin_amdgcn_rcpf((1.0f + e1) * (1.0f + e2));
            const float rg = (1.0f + e2) * inv, ig = (1.0f + e1) * inv;
            const float a = __expf(-8.0f * rg * sp);
            av[r] = a; bv[r] = __builtin_amdgcn_sqrtf(fmaxf(1.0f - a * a, 0.f)) * ig * xcv;
        }
        float A = av[0], B = bv[0];
#pragma unroll
        for (int r = 1; r < 4; ++r) { B = av[r] * B + bv[r]; A = A * av[r]; }
        { const float A1 = __shfl_up(A, 16), B1 = __shfl_up(B, 16); if (q >= 1) { B = A * B1 + B; A = A * A1; } }
        { const float A2 = __shfl_up(A, 32), B2 = __shfl_up(B, 32); if (q >= 2) { B = A * B2 + B; A = A * A2; } }
        const float hend = A * carry + B;
        const float hprev = __shfl_up(hend, 16);
        float h = (q == 0) ? carry : hprev;
        carry = __shfl(hend, 48 + col);
#pragma unroll
        for (int r = 0; r < 4; ++r) { h = av[r] * h + bv[r]; const int tau = tau0 + 4 * q + r; const int pos = d ? (L - 1 - tau) : tau; outb[((size_t)(32 + hb * 4 + nt) * MP + rb + pos) * 16 + col] = f2bf(h); }
        Rg = Rn; Ig = In;
        asm volatile("s_waitcnt lgkmcnt(0)" ::: "memory");
      }
    }
#undef LRU_TILE_WRITE
#undef LRU_MFMA
#undef LRU_LOAD
}

__device__ __forceinline__ void scan_unit(const Params& p, LAS unsigned char* wl, int lane, int j, const bf16_t* Z, bf16_t* SF, bf16_t* SB) {
    if (j < 256) { const int s = 16 + (j >> 6), d = (j >> 5) & 1, g = j & 31; s5_unit(p, wl, s, d, g, lane, Z, d ? SB : SF); }
    else if (j < 512) { const int k = j - 256; const int s = 16 + (k >> 6), d = (k >> 5) & 1, hb = (k >> 2) & 7, nt = k & 3; lru_unit(p, wl, s, d, hb, nt, lane, Z, d ? SB : SF); }
    else if (j < 1536) { const int k = j - 512; const int s = k >> 6, d = (k >> 5) & 1, g = k & 31; s5_unit(p, wl, s, d, g, lane, Z, d ? SB : SF); }
    else { const int k = j - 1536; const int s = k >> 6, d = (k >> 5) & 1, hb = (k >> 2) & 7, nt = k & 3; lru_unit(p, wl, s, d, hb, nt, lane, Z, d ? SB : SF); }
}
__device__ __forceinline__ void phase_scan(const Params& p, LAS unsigned char* lds) {
    int tid = threadIdx.x; asm volatile("" : "+v"(tid)); const int lane = tid & 63, wid = __builtin_amdgcn_readfirstlane(tid >> 6);
    LAS unsigned char* wl = lds + wid * WLDS;
    const bf16_t* Z = (const bf16_t*)(p.ws + OFF_DYN);
    bf16_t* SF = (bf16_t*)(p.ws + OFF_DYN + SZ_Z); bf16_t* SB = (bf16_t*)p.out;
    const int nslots = gridDim.x * 8, slot = wid * gridDim.x + blockIdx.x;
    const bool lpt = (nslots == 2048);
    int u0 = 0, u1 = 0, nu = 0;
    if (lpt) {
        if (slot < 512) { u0 = (slot & 1) * 256 + (slot >> 1); nu = 1; }
        else { const int k = slot - 512; u0 = 512 + (k & 1) * 1024 + (k >> 1); nu = 1;
            if (k < 512) { const int u = 1536 + k; u1 = 512 + (u & 1) * 1024 + (u >> 1); nu = 2; } }
    }
    for (int it = 0;; ++it) {
        int j;
        if (lpt) { if (it >= nu) break; j = it ? u1 : u0; } else { j = slot + it * nslots; if (j >= 2560) break; }
        scan_unit(p, wl, lane, j, Z, SF, SB);
    }
    if (lpt) { if (slot >= 1024) cvt_rest(p, (long)(slot - 1024) * 64 + lane, 1024L * 64); }
    else cvt_rest(p, (long)slot * 64 + lane, (long)nslots * 64);
}

__device__ __forceinline__ void phase_combine(const Params& p) {
    const bf16_t* Z = (const bf16_t*)(p.ws + OFF_DYN);
    bf16_t* SF = (bf16_t*)(p.ws + OFF_DYN + SZ_Z); bf16_t* SB = (bf16_t*)p.out;
    const float* dsk = p.in[14];
    const long total = 64L * R * 2, nth = (long)gridDim.x * blockDim.x;
    int tid = threadIdx.x; asm volatile("" : "+v"(tid));
    for (long t = (long)blockIdx.x * blockDim.x + tid; t < total; t += nth) {
        const int blk = (int)(t / (2L * R)); const int rem = (int)(t - (long)blk * 2 * R); const int r = rem >> 1, c8 = blk * 16 + (rem & 1) * 8;
        const size_t off = ((size_t)blk * MP + r) * 16 + (rem & 1) * 8;
        const u32x4 f = *(const u32x4*)(SF + off), b = *(const u32x4*)(SB + off);
        float o[8];
        const float s0 = bflo(f.x) + bflo(b.x), s1 = bfhi(f.x) + bfhi(b.x), s2 = bflo(f.y) + bflo(b.y), s3 = bfhi(f.y) + bfhi(b.y);
        const float s4 = bflo(f.z) + bflo(b.z), s5 = bfhi(f.z) + bfhi(b.z), s6 = bflo(f.w) + bflo(b.w), s7 = bfhi(f.w) + bfhi(b.w);
        if (c8 < 512) {
            const u32x4 u = *(const u32x4*)(Z + (size_t)r * 1536 + c8); const f32x4 d0 = *(const f32x4*)(dsk + c8), d1 = *(const f32x4*)(dsk + c8 + 4);
            o[0] = gelu_t(s0 + d0[0] * bflo(u.x)); o[1] = gelu_t(s1 + d0[1] * bfhi(u.x)); o[2] = gelu_t(s2 + d0[2] * bflo(u.y)); o[3] = gelu_t(s3 + d0[3] * bfhi(u.y));
            o[4] = gelu_t(s4 + d1[0] * bflo(u.z)); o[5] = gelu_t(s5 + d1[1] * bfhi(u.z)); o[6] = gelu_t(s6 + d1[2] * bflo(u.w)); o[7] = gelu_t(s7 + d1[3] * bfhi(u.w));
            u32x4 w; w.x = pack2(o[0], o[1]); w.y = pack2(o[2], o[3]); w.z = pack2(o[4], o[5]); w.w = pack2(o[6], o[7]);
            *(u32x4*)(SF + off) = w;
        } else {
            const u32x4 u = *(const u32x4*)(Z + (size_t)r * 1536 + 512 + c8);
            o[0] = s0 * gelu_t(bflo(u.x)); o[1] = s1 * gelu_t(bfhi(u.x)); o[2] = s2 * gelu_t(bflo(u.y)); o[3] = s3 * gelu_t(bfhi(u.y));
            o[4] = s4 * gelu_t(bflo(u.z)); o[5] = s5 * gelu_t(bfhi(u.z)); o[6] = s6 * gelu_t(bflo(u.w)); o[7] = s7 * gelu_t(bfhi(u.w));
            u32x4 w; w.x = pack2(o[0], o[1]); w.y = pack2(o[2], o[3]); w.z = pack2(o[4], o[5]); w.w = pack2(o[6], o[7]);
            *(u32x4*)(SB + off) = w;
        }
    }
}

__device__ __forceinline__ void phase_attn(const Params& p) {
    int tid = threadIdx.x; asm volatile("" : "+v"(tid)); const int lane = tid & 63, wid = tid >> 6;
    const bf16_t* QK = (const bf16_t*)(p.ws + OFF_DYN);
    const bf16_t* KT = (const bf16_t*)(p.ws + OFF_DYN + SZ_ROWS);
    const bf16_t* VT = (const bf16_t*)(p.ws + OFF_DYN + SZ_ROWS + SZ_VT);
    bf16_t* O = (bf16_t*)(p.ws + OFF_DYN + SZ_ROWS + 2 * SZ_VT);
    const float* sink = p.in[27];
    const int qi = lane & 31, h = lane >> 5;
    const int nitems = (16 * 65 + 4 * 257) * 16, nw = gridDim.x * 8;
    const float LOG2E = 1.4426950408889634f;
#define ATT_ITEM(IT, hq_, hk_, rb_, L_, q0_, lo_, hi_) do { hq_ = (IT) & 15; const int _tile = (IT) >> 4; hk_ = hq_ >> 2; int _tq; \
        if (_tile < 16 * 65) { const int _s = _tile / 65; _tq = _tile - _s * 65; rb_ = _s * LP; L_ = LP; } else { const int _t2 = _tile - 16 * 65; const int _s = _t2 / 257; _tq = _t2 - _s * 257; rb_ = RP + _s * LS; L_ = LS; } \
        q0_ = _tq * 32; lo_ = (q0_ >= 128) ? 0 : 4 - (q0_ >> 5); hi_ = (L_ - q0_ + 127) >> 5; hi_ = hi_ > 8 ? 8 : hi_; } while (0)
#define ATT_QLOAD(Qd, rb_, L_, q0_, hq_) do { const int _qp = (q0_) + qi; const int _qr = (rb_) + (_qp < (L_) ? _qp : (L_) - 1); \
        _Pragma("unroll") for (int s = 0; s < 4; ++s) Qd[s] = *(const bf16x8*)(QK + (size_t)_qr * 1024 + (hq_) * 64 + 16 * s + 8 * h); } while (0)
#define ATT_LOADX(kf, vr, KB, q0_, L_, rb_, kbase_, vbase_) do { const int _k0 = (q0_) - 128 + 32 * (KB); int _kp = _k0 + qi; _kp = _kp < 0 ? 0 : (_kp > (L_) - 1 ? (L_) - 1 : _kp); \
        const int _kfl = (rb_) + _kp; const bf16_t* _kr = (kbase_) + (size_t)(_kfl >> 4) * 1024 + (_kfl & 15) * 16; \
        _Pragma("unroll") for (int s = 0; s < 4; ++s) kf[s] = *(const u32x4*)(_kr + 256 * s); \
        _Pragma("unroll") for (int sp = 0; sp < 2; ++sp) _Pragma("unroll") for (int hf = 0; hf < 2; ++hf) { int gk = _k0 + 16 * sp + 8 * hf + 4 * h; if (gk < 0 || gk >= (L_)) gk = 0; \
            const int _fl = (rb_) + gk; const bf16_t* _vp = (vbase_) + (size_t)(_fl >> 4) * 1024 + (_fl & 15); \
            _Pragma("unroll") for (int t = 0; t < 2; ++t) vr[sp][t][hf] = *(const u32x2*)(_vp + 512 * t); } } while (0)
#define ATT_BLOCK(kf, vr, KB, SETIDX) do { const int kb = (KB); const int k0 = q0 - 128 + 32 * kb; \
            f32x16 S; _Pragma("unroll") for (int r = 0; r < 16; ++r) S[r] = 0.f; \
            _Pragma("unroll") for (int s = 0; s < 4; ++s) S = __builtin_amdgcn_mfma_f32_32x32x16_bf16(__builtin_bit_cast(bf16x8, kf[s]), Qf[s], S, 0, 0, 0); \
            u32x4 v0[2], v1[2]; \
            _Pragma("unroll") for (int sp = 0; sp < 2; ++sp) { v0[sp].x = vr[sp][0][0].x; v0[sp].y = vr[sp][0][0].y; v0[sp].z = vr[sp][0][1].x; v0[sp].w = vr[sp][0][1].y; \
                v1[sp].x = vr[sp][1][0].x; v1[sp].y = vr[sp][1][0].y; v1[sp].z = vr[sp][1][1].x; v1[sp].w = vr[sp][1][1].y; } \
            if (kb + 2 <= kb_hi) ATT_LOADX(kf, vr, kb + 2, q0, L, rb, kbase, vbase); \
            else if (has_next) { ATT_LOADX(kf, vr, kbn_lo + (SETIDX), q0n, Ln, rbn, kbasen, vbasen); if ((SETIDX) == 0) ATT_QLOAD(Qn, rbn, Ln, q0n, hqn); } \
            const bool full = (kb >= 1) && (kb <= 7) && (k0 >= 0) && (k0 + 31 < L); \
            const int dq = qpos - k0 - 4 * h; const float fdq = (float)dq; \
            float sc[16]; float bm = -1e30f; \
            if (full) { _Pragma("unroll") for (int r = 0; r < 16; ++r) { const float t = fdq - (float)((r & 3) + 8 * (r >> 2)); sc[r] = S[r] - slope * fabsf(t); bm = fmaxf(bm, sc[r]); } } \
            else { _Pragma("unroll") for (int r = 0; r < 16; ++r) { const int kk = (r & 3) + 8 * (r >> 2); const int kp = k0 + kk + 4 * h; int dist = dq - kk; dist = dist < 0 ? -dist : dist; \
                    const bool valid = (dist <= 128) && (kp >= 0) && (kp < L); sc[r] = valid ? (S[r] - slope * (float)dist) : -1e30f; bm = fmaxf(bm, sc[r]); } } \
            bm = fmaxf(bm, __shfl_xor(bm, 32)); \
            const float mn = fmaxf(m, bm), alpha = __builtin_amdgcn_exp2f(m - mn); m = mn; \
            float ps = 0.f; float pv[16]; \
            _Pragma("unroll") for (int r = 0; r < 16; ++r) { pv[r] = __builtin_amdgcn_exp2f(sc[r] - mn); ps += pv[r]; } \
            l = l * alpha + ps; \
            if (__builtin_amdgcn_ballot_w64(alpha < 1.0f) != 0ull) { _Pragma("unroll") for (int r = 0; r < 16; ++r) { O0[r] *= alpha; O1[r] *= alpha; } } \
            _Pragma("unroll") for (int sp = 0; sp < 2; ++sp) { \
                u32x4 pw; pw.x = pack2(pv[8 * sp + 0], pv[8 * sp + 1]); pw.y = pack2(pv[8 * sp + 2], pv[8 * sp + 3]); pw.z = pack2(pv[8 * sp + 4], pv[8 * sp + 5]); pw.w = pack2(pv[8 * sp + 6], pv[8 * sp + 7]); \
                const bf16x8 Pf = __builtin_bit_cast(bf16x8, pw); \
                O0 = __builtin_amdgcn_mfma_f32_32x32x16_bf16(__builtin_bit_cast(bf16x8, v0[sp]), Pf, O0, 0, 0, 0); \
                O1 = __builtin_amdgcn_mfma_f32_32x32x16_bf16(__builtin_bit_cast(bf16x8, v1[sp]), Pf, O1, 0, 0, 0); } } while (0)
    int it = blockIdx.x * 8 + wid;
    if (it < nitems) {
        int hq, hk, rb, L, q0, kb_lo, kb_hi;
        ATT_ITEM(it, hq, hk, rb, L, q0, kb_lo, kb_hi);
        bf16x8 Qf[4];
        ATT_QLOAD(Qf, rb, L, q0, hq);
        u32x4 kfA[4], kfB[4]; u32x2 vrA[2][2][2], vrB[2][2][2];
        { const bf16_t* kbase = KT + (size_t)hk * (MP / 16) * 1024 + 8 * h; const bf16_t* vbase = VT + ((size_t)hk * (MP / 16) * 64 + qi) * 16;
          ATT_LOADX(kfA, vrA, kb_lo, q0, L, rb, kbase, vbase); ATT_LOADX(kfB, vrB, kb_lo + 1, q0, L, rb, kbase, vbase); }
        for (;;) {
            const int itn = it + nw; const bool has_next = itn < nitems;
            int hqn = 0, hkn = 0, rbn = 0, Ln = LP, q0n = 0, kbn_lo = 4, kbn_hi = 8;
            if (has_next) ATT_ITEM(itn, hqn, hkn, rbn, Ln, q0n, kbn_lo, kbn_hi);
            const bf16_t* kbase = KT + (size_t)hk * (MP / 16) * 1024 + 8 * h; const bf16_t* vbase = VT + ((size_t)hk * (MP / 16) * 64 + qi) * 16;
            const bf16_t* kbasen = KT + (size_t)hkn * (MP / 16) * 1024 + 8 * h; const bf16_t* vbasen = VT + ((size_t)hkn * (MP / 16) * 64 + qi) * 16;
            bf16x8 Qn[4];
#pragma unroll
            for (int s = 0; s < 4; ++s) Qn[s] = Qf[s];
            const int qpos = q0 + qi;
            const float slope = exp2f(-0.5f * (float)(hq + 1)) * LOG2E;
            float m = sink[hq] * LOG2E, l = (h == 0) ? 1.0f : 0.0f;
            f32x16 O0, O1;
#pragma unroll
            for (int r = 0; r < 16; ++r) { O0[r] = 0.f; O1[r] = 0.f; }
            for (int kb2 = kb_lo; kb2 <= kb_hi; kb2 += 2) {
                ATT_BLOCK(kfA, vrA, kb2, 0);
                if (kb2 + 1 <= kb_hi) ATT_BLOCK(kfB, vrB, kb2 + 1, 1);
            }
            l += __shfl_xor(l, 32);
            const float inv = 1.0f / l;
            if (qpos < L) {
                bf16_t* orow = O + (size_t)(rb + qpos) * 1024 + hq * 64 + 4 * h;
#pragma unroll
                for (int r4 = 0; r4 < 4; ++r4) {
                    u32x2 w0; w0.x = pack2(O0[4 * r4] * inv, O0[4 * r4 + 1] * inv); w0.y = pack2(O0[4 * r4 + 2] * inv, O0[4 * r4 + 3] * inv); *(u32x2*)(orow + 8 * r4) = w0;
                    u32x2 w1; w1.x = pack2(O1[4 * r4] * inv, O1[4 * r4 + 1] * inv); w1.y = pack2(O1[4 * r4 + 2] * inv, O1[4 * r4 + 3] * inv); *(u32x2*)(orow + 32 + 8 * r4) = w1;
                }
            }
            if (!has_next) break;
            it = itn; hq = hqn; hk = hkn; rb = rbn; L = Ln; q0 = q0n; kb_lo = kbn_lo; kb_hi = kbn_hi;
#pragma unroll
            for (int s = 0; s < 4; ++s) Qf[s] = Qn[s];
        }
    }
#undef ATT_BLOCK
#undef ATT_LOADX
#undef ATT_QLOAD
#undef ATT_ITEM
}

__device__ __forceinline__ void phase_final(const Params& p) {
    int tid = threadIdx.x; asm volatile("" : "+v"(tid)); const int lane = tid & 63, wid = tid >> 6;
    const bf16_t* H = (const bf16_t*)(p.ws + OFF_HPAD) + 8 * 1024; const float* rss = (const float*)(p.ws + OFF_RSS);
    const float* g = p.in[5];
    const int nw = gridDim.x * 8;
    for (int r0 = blockIdx.x * 8 + wid; r0 < R; r0 += 2 * nw) {
        u32x2 hw[2][4]; float rs[2]; bool ok[2]; size_t orow[2];
#pragma unroll
        for (int j = 0; j < 2; ++j) {
            const int r = r0 + j * nw; ok[j] = false; rs[j] = 0.f; orow[j] = 0;
            if (r < R) { int pos, len; row_pos(r, pos, len);
                if (pos >= 16) { ok[j] = true;
                    if (r < RP) { const int s = r / LP; orow[j] = (size_t)s * 2048 + pos - 16; } else { const int s = (r - RP) / LS; orow[j] = (size_t)16 * 2048 + (size_t)s * 8192 + pos - 16; }
                    rs[j] = rowscale(rss, r);
#pragma unroll
                    for (int i = 0; i < 4; ++i) hw[j][i] = __builtin_nontemporal_load((const u32x2*)(H + (size_t)r * 1024 + i * 256 + lane * 4)); } }
        }
#pragma unroll
        for (int j = 0; j < 2; ++j) {
            if (!ok[j]) continue;
            float* op = p.out + orow[j] * 1024;
#pragma unroll
            for (int i = 0; i < 4; ++i) { const int c = i * 256 + lane * 4; const f32x4 gv = *(const f32x4*)(g + c); const u32x2 w = hw[j][i];
                f32x4 o; o[0] = bflo(w.x) * rs[j] * gv[0]; o[1] = bfhi(w.x) * rs[j] * gv[1]; o[2] = bflo(w.y) * rs[j] * gv[2]; o[3] = bfhi(w.y) * rs[j] * gv[3]; __builtin_nontemporal_store(o, (f32x4*)(op + c)); }
        }
    }
}

#define XB_TMO      128
#define XB_XCNT(j)  (256  + 64 * (j))
#define XB_XSUB(j)  (1280 + 64 * (j))
#define XB_XGEN(j)  (2304 + 64 * (j))
#define XB_TOP      3328
#define XB_TOPGEN   3392
#define XCD_BAR_WORDS 3456
#define XB_SPIN_CAP (1u << 22)
__device__ __forceinline__ unsigned xb_ld(unsigned* p)              { return __hip_atomic_load(p, __ATOMIC_RELAXED, __HIP_MEMORY_SCOPE_AGENT); }
__device__ __forceinline__ unsigned xb_add(unsigned* p, unsigned v) { return __hip_atomic_fetch_add(p, v, __ATOMIC_RELAXED, __HIP_MEMORY_SCOPE_AGENT); }
__device__ __forceinline__ unsigned xb_xcc_id() { return (unsigned)__builtin_amdgcn_s_getreg((3 << 11) | 20) & 0xFu; }
#define XB_SPIN(cond, bar) do { unsigned _sp = 0; while (cond) { __builtin_amdgcn_s_sleep(1); \
    if ((++_sp & 255u) == 0u) { if (xb_ld(&(bar)[XB_TMO])) break; if (_sp > XB_SPIN_CAP) { atomicAdd(&(bar)[XB_TMO], 1u); break; } } } } while (0)
struct XcdBarrier { unsigned* bar; unsigned x; volatile LAS unsigned* st; };
__device__ __forceinline__ XcdBarrier xcd_barrier_post(unsigned* bar, volatile LAS unsigned* st) {
    XcdBarrier b; b.bar = bar; b.x = xb_xcc_id(); b.st = st;
    if (threadIdx.x == 0) (void)xb_add(&bar[XB_XCNT(b.x)], 1u);
    return b;
}
__device__ __forceinline__ void xcd_barrier_complete(unsigned* bar, unsigned x, unsigned& nloc, unsigned& nx) {
    const unsigned G = gridDim.x * gridDim.y * gridDim.z;
    unsigned sum, cnt, mine, sp = 0u;
    for (;;) {
        sum = 0u; cnt = 0u; mine = 0u;
#pragma unroll
        for (unsigned j = 0; j < 16; ++j) { const unsigned c = xb_ld(&bar[XB_XCNT(j)]); sum += c; cnt += (c > 0u) ? 1u : 0u; mine = (j == x) ? c : mine; }
        if (sum == G) break;
        __builtin_amdgcn_s_sleep(1);
        if ((++sp & 255u) == 0u) { if (xb_ld(&bar[XB_TMO])) break; if (sp > XB_SPIN_CAP) { atomicAdd(&bar[XB_TMO], 1u); break; } }
    }
    nloc = mine > 0u ? mine : 1u; nx = cnt > 0u ? cnt : 1u;
}
__device__ __forceinline__ void xcd_barrier(const XcdBarrier& b) {
    asm volatile("s_waitcnt vmcnt(0)" ::: "memory");
    __syncthreads();
    if (threadIdx.x == 0) {
        unsigned* bar = b.bar;
        __builtin_amdgcn_s_waitcnt(0);
        unsigned nloc = b.st[0], nx = b.st[1];
        if (nloc == 0u) { xcd_barrier_complete(bar, b.x, nloc, nx); b.st[0] = nloc; b.st[1] = nx; }
        const unsigned old = xb_add(&bar[XB_XSUB(b.x)], 1u);
        const unsigned gen = old / nloc;
        if (old + 1u == (gen + 1u) * nloc) {
            __builtin_amdgcn_fence(__ATOMIC_RELEASE, "agent");
            asm volatile("s_waitcnt vmcnt(0)" ::: "memory");
            const unsigned og = xb_add(&bar[XB_TOP], 1u);
            const unsigned tg = og / nx;
            if (og + 1u == (tg + 1u) * nx) xb_add(&bar[XB_TOPGEN], 1u);
            else XB_SPIN(xb_ld(&bar[XB_TOPGEN]) == tg, bar);
            __builtin_amdgcn_fence(__ATOMIC_ACQUIRE, "agent");
            xb_add(&bar[XB_XGEN(b.x)], 1u);
            asm volatile("s_waitcnt vmcnt(0)" ::: "memory");
        } else {
            XB_SPIN(xb_ld(&bar[XB_XGEN(b.x)]) == gen, bar);
            __builtin_amdgcn_fence(__ATOMIC_ACQUIRE, "agent");
            asm volatile("s_waitcnt vmcnt(0)" ::: "memory");
        }
    }
    __syncthreads();
}

constexpr int NPHASE = 14;
#ifndef REP_PH
#define REP_PH -1
#define REP_N 1
#endif
__global__ void __launch_bounds__(512, 2) mega(Params p) {
    extern __shared__ __attribute__((aligned(16))) unsigned char smem[];
    LAS unsigned char* lds = (LAS unsigned char*)smem;
    if (threadIdx.x < 4) ((LAS unsigned*)(lds + LDS_BARW))[threadIdx.x] = 0u;
    __syncthreads();
    XcdBarrier xbar = xcd_barrier_post((unsigned*)(p.ws + OFF_BAR), (volatile LAS unsigned*)(lds + LDS_BARW));
    unsigned char* ws = p.ws;
    bf16_t* H = (bf16_t*)(ws + OFF_HPAD) + 8 * 1024; float* rss = (float*)(ws + OFF_RSS);
    const char* DYN = (const char*)(ws + OFF_DYN);
    const int G = gridDim.x, bx = blockIdx.x;
    for (int phx = p.ph_lo, rep = 0; phx < p.ph_hi; ) {
        const int ph = phx;
        if (ph == 0) phase_prep(p);
        else if (ph == 1 || ph == 8) {
            const bool at = (ph == 8);
            pg8::GemmDesc g{(const char*)H, (const char*)H, 1 << 30, 1024, (const char*)(ws + (at ? OFF_WQKV : OFF_WIN)), 1024, 0}; pg8::StaticOrder S; S.init(NT256, 6, G, bx);
            EpiScale E{(bf16_t*)(ws + OFF_DYN), at ? 1024 : 1536, rss, (bf16_t*)(ws + OFF_DYN + SZ_ROWS + SZ_VT), at ? 5 : (1 << 30), (bf16_t*)(ws + OFF_DYN + SZ_ROWS)}; pg8::gemm_phase<false>(lds, g, S, E);
        } else if (ph == 2) phase_scan(p, lds);
        else if (ph == 3) phase_combine(p);
        else if (ph == 4) {
            pg8::GemmDesc g{DYN + SZ_Z, DYN + SZ_Z, 1 << 30, 1024, (const char*)(ws + OFF_WGLU), 512, 1}; pg8::StaticOrder S; S.init(NT256, 2, G, bx);
            EpiGlu E{(const bf16_t*)(DYN + SZ_Z), (bf16_t*)p.out, p.in[16]}; pg8::gemm_phase<false>(lds, g, S, E);
        } else if (ph == 5 || ph == 7 || ph == 10 || ph == 12) {
            const char* A1; const char* A2; int split = 1 << 30, lda = 1024; size_t woff;
            if (ph == 5) { A1 = (const char*)p.out; A2 = A1; woff = OFF_WOUT; }
            else if (ph == 10) { A1 = DYN + SZ_ROWS + 2 * SZ_VT; A2 = A1; woff = OFF_WO; }
            else { A1 = DYN; A2 = (const char*)p.out; split = RSPLIT / 256; lda = DFF; woff = (ph == 7) ? OFF_WDN0 : OFF_WDN1; }
            pg8::GemmDesc g{A1, A2, split, lda, (const char*)(ws + woff), lda, ph == 5 ? 1 : 0}; pg8::StaticOrder S; S.init(ph == 12 ? 256 : NT256, 4, G, bx);
            EpiRes E{H, rss, ph == 12 ? 1 : 0}; pg8::gemm_phase<false>(lds, g, S, E);
        } else if (ph == 6 || ph == 11) {
            const int l = ph == 6 ? 0 : 1;
            pg8::GemmDesc g{(const char*)H, (const char*)H, 1 << 30, 1024, (const char*)(ws + (l ? OFF_WUP1 : OFF_WUP0)), 1024, 0}; pg8::StaticOrder S; S.init(NTUP, 22, G, bx);
            EpiUp E{(bf16_t*)(ws + OFF_DYN), (bf16_t*)p.out, rss, p.in[29] + (size_t)l * 3 * 5632, p.in[30] + (size_t)l * 5632, l}; pg8::gemm_phase<true>(lds, g, S, E);
        } else if (ph == 9) phase_attn(p);
        else if (ph == 13) phase_final(p);
        ++rep; if (!(ph == p.rep_ph && rep < p.rep_n)) { ++phx; rep = 0; }
        if (phx < p.ph_hi) { if (p.ph_lo < 0) cg::this_grid().sync(); else xcd_barrier(xbar); }
    }
}

extern "C" void kernel_launch(void* const* d_in, const int* in_sizes, int n_in, void* d_out, int out_size, void* d_ws, size_t ws_size, hipStream_t stream) {
    static int grid = 0;
    if (grid == 0) {
        if (n_in != 32 || ws_size < WS_NEED) { fprintf(stderr, "kernel_launch: bad args n_in %d ws %zu need %zu\n", n_in, ws_size, (size_t)WS_NEED); grid = -1; return; }
        int dev = 0, cus = 0, per_cu = 0;
        hipGetDevice(&dev); hipDeviceGetAttribute(&cus, hipDeviceAttributeMultiprocessorCount, dev);
        hipFuncSetAttribute((const void*)mega, hipFuncAttributeMaxDynamicSharedMemorySize, LDS_BYTES);
        hipOccupancyMaxActiveBlocksPerMultiprocessor(&per_cu, (const void*)mega, 512, LDS_BYTES);
        (void)hipGetLastError();
        if (per_cu < 1) per_cu = 1;
        grid = cus * 1;
    }
    if (grid < 0) return;
    (void)hipMemsetAsync((char*)d_ws + OFF_BAR, 0, SZ_BAR, stream);
    Params p{};
    for (int i = 0; i < 32; ++i) p.in[i] = (const float*)d_in[i];
    p.out = (float*)d_out; p.ws = (unsigned char*)d_ws;
#if defined(MULTI_LAUNCH)
    for (int ph = 0; ph < NPHASE; ++ph) { p.ph_lo = ph; p.ph_hi = ph + 1; hipLaunchKernelGGL(mega, dim3(grid), dim3(512), LDS_BYTES, stream, p); }
#else
    p.ph_lo = 0; p.ph_hi = NPHASE; p.rep_ph = REP_PH; p.rep_n = REP_N;
    void* args[] = {&p};
    hipError_t e = hipLaunchCooperativeKernel((const void*)mega, dim3(grid), dim3(512), args, LDS_BYTES, stream);
    if (e != hipSuccess) fprintf(stderr, "cooperative launch failed: %s (grid %d)\n", hipGetErrorString(e), grid);
#endif
}
```
